# Optimizing an MI355X kernel written in HIP

```python
import math
import jax, jax.numpy as jnp
from jax import lax
import numpy as np

D_MODEL = 1024
BATCH = 8
SEQ = 2048
DEPTH = 1
DEC_BATCH = 32
DEC_SEQ = 16
PAST_LEN = 2048

CHUNK = 64
S5_GROUP = 16
S5_GROUPS = 32
S5_WIDTH = S5_GROUP * S5_GROUPS
S5_STATE = 64
LRU_WIDTH = D_MODEL
LRU_HEADS = 16
LRU_HEAD_DIM = LRU_WIDTH // LRU_HEADS
LRU_C = 8.0
CONV_W = 4
IN_COLS = 2 * S5_WIDTH + 2 * LRU_WIDTH + 2 * D_MODEL
EPS = 1e-6
DT_MIN = 1e-3
DT_MAX = 1e-1

kernel_name = 'hybrid_s5_rglru_stream_step'


def _f32(a):
    return a.astype(jnp.float32)


def rmsnorm(x, g):
    xf = _f32(x)
    return xf * lax.rsqrt(jnp.mean(xf * xf, axis=-1, keepdims=True) + EPS) * _f32(g)


def _complex_affine_combine(e1, e2):
    ar1, ai1, br1, bi1 = e1
    ar2, ai2, br2, bi2 = e2
    return (ar2 * ar1 - ai2 * ai1,
            ar2 * ai1 + ai2 * ar1,
            ar2 * br1 - ai2 * bi1 + br2,
            ar2 * bi1 + ai2 * br1 + bi2)


def s5_mixer(u, h0, lam_re, lam_im, log_dt, b_re, b_im, c_re, c_im, d):
    bt, L, _ = u.shape
    ug = u.reshape(bt, L, S5_GROUPS, S5_GROUP)
    lam_re = _f32(lam_re)
    lam_im = _f32(lam_im)
    dt = jnp.exp(_f32(log_dt))[:, None]
    mag = jnp.exp(lam_re * dt)
    ang = lam_im * dt
    lb_re = mag * jnp.cos(ang)
    lb_im = mag * jnp.sin(ang)
    den = lam_re * lam_re + lam_im * lam_im
    nr = lb_re - 1.0
    coef_re = (nr * lam_re + lb_im * lam_im) / den
    coef_im = (lb_im * lam_re - nr * lam_im) / den
    bu_re = jnp.einsum('blgh,gph->blgp', ug, _f32(b_re))
    bu_im = jnp.einsum('blgh,gph->blgp', ug, _f32(b_im))
    x_re = coef_re * bu_re - coef_im * bu_im
    x_im = coef_re * bu_im + coef_im * bu_re
    a_re = jnp.broadcast_to(lb_re, x_re.shape)
    a_im = jnp.broadcast_to(lb_im, x_im.shape)
    A_re, A_im, H_re, H_im = lax.associative_scan(
        _complex_affine_combine, (a_re, a_im, x_re, x_im), axis=1)
    h0f = _f32(h0)
    h0_re = h0f[:, None, :, :, 0]
    h0_im = h0f[:, None, :, :, 1]
    s_re = H_re + A_re * h0_re - A_im * h0_im
    s_im = H_im + A_re * h0_im + A_im * h0_re
    y = (jnp.einsum('blgp,ghp->blgh', s_re, _f32(c_re))
         - jnp.einsum('blgp,ghp->blgh', s_im, _f32(c_im))
         + ug * _f32(d))
    h_last = jnp.stack([s_re[:, -1], s_im[:, -1]], axis=-1)
    return y.reshape(bt, L, S5_WIDTH), h_last


def causal_conv(u, buf, w, b):
    L = u.shape[1]
    padded = jnp.concatenate([_f32(buf), u], axis=1)
    wf = _f32(w)
    y = _f32(b)
    for k in range(CONV_W):
        y = y + padded[:, k:k + L] * wf[k]
    return y, padded[:, -(CONV_W - 1):]


def rglru(xc, h0, wa, ba, wx, bx, lam):
    bt, L, _ = xc.shape
    xh = xc.reshape(bt, L, LRU_HEADS, LRU_HEAD_DIM)
    r = jax.nn.sigmoid(jnp.einsum('blhi,hij->blhj', xh, _f32(wa)) + _f32(ba)).reshape(bt, L, LRU_WIDTH)
    i = jax.nn.sigmoid(jnp.einsum('blhi,hij->blhj', xh, _f32(wx)) + _f32(bx)).reshape(bt, L, LRU_WIDTH)
    log_a = -LRU_C * r * jax.nn.softplus(-_f32(lam))
    a = jnp.exp(log_a)
    g = jnp.sqrt(jnp.maximum(-jnp.expm1(2.0 * log_a), 0.0)) * (i * xc)

    def step(h, inp):
        a_t, g_t = inp
        h = a_t * h + g_t
        return h, h

    h_last, hs = lax.scan(step, _f32(h0), (jnp.swapaxes(a, 0, 1), jnp.swapaxes(g, 0, 1)))
    return jnp.swapaxes(hs, 0, 1), h_last


def hybrid_layer(x, s5_h0, lru_h0, conv_buf, ln_g, w_in, lam_re, lam_im, log_dt, b_re, b_im,
                 c_re, c_im, d, w_glu, b_glu, conv_w, conv_b, wa, ba, wx, bx, lam,
                 w_pa, w_pb, w_out):
    h = rmsnorm(x, ln_g)
    proj = h @ _f32(w_in)
    cuts = [S5_WIDTH, 2 * S5_WIDTH, 2 * S5_WIDTH + LRU_WIDTH,
            2 * S5_WIDTH + 2 * LRU_WIDTH, 2 * S5_WIDTH + 2 * LRU_WIDTH + D_MODEL]
    u_a, z_a, u_b, z_b, g_a, g_b = jnp.split(proj, cuts, axis=-1)
    y_a, s5_new = s5_mixer(u_a, s5_h0, lam_re, lam_im, log_dt, b_re, b_im, c_re, c_im, d)
    y_a = jax.nn.gelu(y_a)
    y_a = y_a * jax.nn.sigmoid(y_a @ _f32(w_glu) + _f32(b_glu))
    p_a = (y_a * jax.nn.silu(z_a)) @ _f32(w_pa)
    xc, conv_new = causal_conv(u_b, conv_buf, conv_w, conv_b)
    y_b, lru_new = rglru(xc, lru_h0, wa, ba, wx, bx, lam)
    p_b = (y_b * jax.nn.silu(z_b)) @ _f32(w_pb)
    m = jax.nn.sigmoid(g_a) * p_a + jax.nn.sigmoid(g_b) * p_b
    out = _f32(x) + m @ _f32(w_out)
    return out, s5_new, lru_new, conv_new


def setup_inputs(seed: int = 0) -> dict:
    key = jax.random.key(seed)
    ks = jax.random.split(key, 32)
    f = jnp.float32
    nrm = lambda k, s, sc: sc * jax.random.normal(k, s, f)
    x_prompt = nrm(ks[0], (BATCH, SEQ, D_MODEL), 1.0)
    x_sample = nrm(ks[1], (DEC_BATCH, DEC_SEQ, D_MODEL), 1.0)
    state_s5 = nrm(ks[2], (DEPTH, DEC_BATCH, S5_GROUPS, S5_STATE, 2), 0.3)
    state_lru = nrm(ks[3], (DEPTH, DEC_BATCH, LRU_WIDTH), 0.5)
    state_conv = nrm(ks[4], (DEPTH, DEC_BATCH, CONV_W - 1, LRU_WIDTH), 1.0)
    ln_gain = 1.0 + nrm(ks[5], (DEPTH, D_MODEL), 0.05)
    w_in = nrm(ks[6], (DEPTH, D_MODEL, IN_COLS), D_MODEL ** -0.5)
    s5_lambda_re = -0.5 * jnp.exp(nrm(ks[7], (DEPTH, S5_GROUPS, S5_STATE), 0.05))
    s5_lambda_im = (math.pi * jnp.arange(S5_STATE, dtype=f)[None, None, :]
                    + nrm(ks[8], (DEPTH, S5_GROUPS, S5_STATE), 0.02))
    s5_log_dt = jax.random.uniform(ks[9], (DEPTH, S5_GROUPS), f,
                                   math.log(DT_MIN), math.log(DT_MAX))
    s5_b_re = nrm(ks[10], (DEPTH, S5_GROUPS, S5_STATE, S5_GROUP), (2.0 * S5_GROUP) ** -0.5)
    s5_b_im = nrm(ks[11], (DEPTH, S5_GROUPS, S5_STATE, S5_GROUP), (2.0 * S5_GROUP) ** -0.5)
    s5_c_re = nrm(ks[12], (DEPTH, S5_GROUPS, S5_GROUP, S5_STATE), S5_STATE ** -0.5)
    s5_c_im = nrm(ks[13], (DEPTH, S5_GROUPS, S5_GROUP, S5_STATE), S5_STATE ** -0.5)
    s5_d = nrm(ks[14], (DEPTH, S5_GROUPS, S5_GROUP), 1.0)
    w_glu = nrm(ks[15], (DEPTH, S5_WIDTH, S5_WIDTH), S5_WIDTH ** -0.5)
    b_glu = nrm(ks[16], (DEPTH, S5_WIDTH), 0.01)
    conv_w = nrm(ks[17], (DEPTH, CONV_W, LRU_WIDTH), CONV_W ** -0.5)
    conv_b = nrm(ks[18], (DEPTH, LRU_WIDTH), 0.01)
    lru_wa = nrm(ks[19], (DEPTH, LRU_HEADS, LRU_HEAD_DIM, LRU_HEAD_DIM), LRU_HEAD_DIM ** -0.5)
    lru_ba = nrm(ks[20], (DEPTH, LRU_HEADS, LRU_HEAD_DIM), 0.01)
    lru_wx = nrm(ks[21], (DEPTH, LRU_HEADS, LRU_HEAD_DIM, LRU_HEAD_DIM), LRU_HEAD_DIM ** -0.5)
    lru_bx = nrm(ks[22], (DEPTH, LRU_HEADS, LRU_HEAD_DIM), 0.01)
    a_c = jax.random.uniform(ks[23], (DEPTH, LRU_WIDTH), f, 0.9, 0.999)
    a_base = a_c ** (1.0 / LRU_C)
    lru_lambda = jnp.log(a_base) - jnp.log1p(-a_base)
    w_pa = nrm(ks[24], (DEPTH, S5_WIDTH, D_MODEL), S5_WIDTH ** -0.5)
    w_pb = nrm(ks[25], (DEPTH, LRU_WIDTH, D_MODEL), LRU_WIDTH ** -0.5)
    w_out = nrm(ks[26], (DEPTH, D_MODEL, D_MODEL), D_MODEL ** -0.5)
    final_gain = 1.0 + nrm(ks[27], (D_MODEL,), 0.05)
    return {'x_prompt': x_prompt, 'x_sample': x_sample, 'state_s5': state_s5,
            'state_lru': state_lru, 'state_conv': state_conv, 'ln_gain': ln_gain,
            'w_in': w_in, 's5_lambda_re': s5_lambda_re, 's5_lambda_im': s5_lambda_im,
            's5_log_dt': s5_log_dt, 's5_b_re': s5_b_re, 's5_b_im': s5_b_im,
            's5_c_re': s5_c_re, 's5_c_im': s5_c_im, 's5_d': s5_d, 'w_glu': w_glu,
            'b_glu': b_glu, 'conv_w': conv_w, 'conv_b': conv_b, 'lru_wa': lru_wa,
            'lru_ba': lru_ba, 'lru_wx': lru_wx, 'lru_bx': lru_bx, 'lru_lambda': lru_lambda,
            'w_pa': w_pa, 'w_pb': w_pb, 'w_out': w_out, 'final_gain': final_gain}


def reference(x_prompt, x_sample, state_s5, state_lru, state_conv, ln_gain, w_in,
              s5_lambda_re, s5_lambda_im, s5_log_dt, s5_b_re, s5_b_im, s5_c_re, s5_c_im,
              s5_d, w_glu, b_glu, conv_w, conv_b, lru_wa, lru_ba, lru_wx, lru_bx,
              lru_lambda, w_pa, w_pb, w_out, final_gain):
    def run_group(x, s5_init, lru_init, conv_init):
        h = _f32(x)
        s5_out, lru_out, conv_out = [], [], []
        for l in range(DEPTH):
            h, s5_n, lru_n, conv_n = hybrid_layer(
                h, s5_init[l], lru_init[l], conv_init[l], ln_gain[l], w_in[l],
                s5_lambda_re[l], s5_lambda_im[l], s5_log_dt[l], s5_b_re[l], s5_b_im[l],
                s5_c_re[l], s5_c_im[l], s5_d[l], w_glu[l], b_glu[l], conv_w[l], conv_b[l],
                lru_wa[l], lru_ba[l], lru_wx[l], lru_bx[l], lru_lambda[l],
                w_pa[l], w_pb[l], w_out[l])
            s5_out.append(s5_n)
            lru_out.append(lru_n)
            conv_out.append(conv_n)
        y = rmsnorm(h, final_gain).astype(x.dtype)
        return y, jnp.stack(s5_out), jnp.stack(lru_out), jnp.stack(conv_out)

    sdt = state_s5.dtype
    zs5 = [jnp.zeros((BATCH, S5_GROUPS, S5_STATE, 2), jnp.float32)] * DEPTH
    zlru = [jnp.zeros((BATCH, LRU_WIDTH), jnp.float32)] * DEPTH
    zconv = [jnp.zeros((BATCH, CONV_W - 1, LRU_WIDTH), jnp.float32)] * DEPTH
    y_prompt, s5_p, lru_p, conv_p = run_group(x_prompt, zs5, zlru, zconv)
    y_sample, s5_s, lru_s, conv_s = run_group(
        x_sample, [state_s5[l] for l in range(DEPTH)], [state_lru[l] for l in range(DEPTH)],
        [state_conv[l] for l in range(DEPTH)])
    return (y_prompt, y_sample,
            s5_p.astype(sdt), lru_p.astype(state_lru.dtype), conv_p.astype(state_conv.dtype),
            s5_s.astype(sdt), lru_s.astype(state_lru.dtype), conv_s.astype(state_conv.dtype))
```

```cpp
#include <hip/hip_runtime.h>
#include <hip/hip_cooperative_groups.h>
#include <stdint.h>
#include <cstdio>
namespace cg = cooperative_groups;

#ifndef MULTI
#define MULTI 1
#endif

typedef unsigned short bf16_t;
typedef short bf16x8 __attribute__((ext_vector_type(8)));
typedef float f32x4 __attribute__((ext_vector_type(4)));
typedef float f32x2 __attribute__((ext_vector_type(2)));
typedef unsigned u32x4 __attribute__((ext_vector_type(4)));
typedef unsigned u32x2 __attribute__((ext_vector_type(2)));

#define NT 512
constexpr int NTOK = 16896, NPTOK = 16384;
constexpr int NSUB = 1056, NSUBP = 1280;
constexpr int LDS_BYTES = 147456;

struct Params { const float* in[28]; float* out; char* ws; };

constexpr size_t OFF_BAR   = 0;
constexpr size_t OFF_WTIN  = 16384;
constexpr size_t OFF_WTGLU = OFF_WTIN  + 5120ull * 1024 * 2;
constexpr size_t OFF_WTPA  = OFF_WTGLU + 512ull * 512 * 2;
constexpr size_t OFF_WTPB  = OFF_WTPA  + 1024ull * 512 * 2;
constexpr size_t OFF_WTOUT = OFF_WTPB  + 1024ull * 1024 * 2;
constexpr size_t OFF_WTG   = OFF_WTOUT + 1024ull * 1024 * 2;
constexpr size_t OFF_BTE   = OFF_WTG   + 16ull * 128 * 64 * 2;
constexpr size_t OFF_BTY   = OFF_BTE   + 32ull * 128 * 256 * 2;
constexpr size_t OFF_UAX   = OFF_BTY   + 32ull * 256 * 384 * 2;
constexpr size_t OFF_SZA   = OFF_UAX   + 32ull * NSUBP * 384 * 2;
constexpr size_t OFF_REGA  = OFF_SZA   + (size_t)NTOK * 512 * 2;
constexpr size_t OFF_REGB  = OFF_REGA  + (size_t)NTOK * 1024 * 2;
constexpr size_t OFF_REGC  = OFF_REGB  + (size_t)NTOK * 1024 * 2;
constexpr size_t OFF_SZB   = OFF_REGC  + (size_t)NTOK * 1024 * 2;
constexpr size_t OFF_SEND  = OFF_SZB   + (size_t)NTOK * 1024 * 2;
constexpr size_t OFF_PEND  = OFF_SEND  + 32ull * NSUBP * 128 * 4;
constexpr size_t OFF_HEND  = OFF_PEND  + (size_t)NSUB * 1024 * 4;
constexpr size_t OFF_HIN   = OFF_HEND  + (size_t)NSUB * 1024 * 4;
constexpr size_t WS_TOTAL  = OFF_HIN   + (size_t)NSUB * 1024 * 4;

constexpr size_t O_Y = 0;
constexpr size_t O_S5P = 17301504, O_LRUP = 17334272, O_CONVP = 17342464;
constexpr size_t O_S5S = 17367040, O_LRUS = 17498112, O_CONVS = 17530880;

__device__ __forceinline__ unsigned cvt_pk_bf16(float lo, float hi) { unsigned r; asm("v_cvt_pk_bf16_f32 %0, %1, %2" : "=v"(r) : "v"(lo), "v"(hi)); return r; }
__device__ __forceinline__ bf16_t f2bf(float f) { return (bf16_t)(cvt_pk_bf16(f, 0.f) & 0xffffu); }
__device__ __forceinline__ float bf2f(unsigned b) { return __uint_as_float(b << 16); }
__device__ __forceinline__ float bflo(unsigned w) { return __uint_as_float(w << 16); }
__device__ __forceinline__ float bfhi(unsigned w) { return __uint_as_float(w & 0xffff0000u); }
__device__ __forceinline__ float sigm(float x) { return __builtin_amdgcn_rcpf(1.f + __expf(-x)); }
__device__ __forceinline__ float silu(float x) { return x * sigm(x); }
__device__ __forceinline__ float gelu_t(float x) { return x * sigm(1.5957691216f * (x + 0.044715f * x * x * x)); }
__device__ __forceinline__ const float* xrow(const Params& p, int tok) {
    return tok < NPTOK ? p.in[0] + (size_t)tok * 1024 : p.in[1] + (size_t)(tok - NPTOK) * 1024;
}
__device__ __forceinline__ void gl_lds16(const void* g, void* l) {
    __builtin_amdgcn_global_load_lds((const unsigned*)g, (__attribute__((address_space(3))) unsigned*)l, 16, 0, 0);
}

#define XB_TMO      128
#define XB_XCNT(j)  (256  + 64 * (j))
#define XB_XSUB(j)  (1280 + 64 * (j))
#define XB_XGEN(j)  (2304 + 64 * (j))
#define XB_TOP      3328
#define XB_TOPGEN   3392
#define XCD_BAR_WORDS 3456
#define XB_SPIN_CAP (1u << 20)
#define LAS __attribute__((address_space(3)))
__device__ __forceinline__ unsigned xb_ld(unsigned* p)              { return __hip_atomic_load(p, __ATOMIC_RELAXED, __HIP_MEMORY_SCOPE_AGENT); }
__device__ __forceinline__ unsigned xb_add(unsigned* p, unsigned v) { return __hip_atomic_fetch_add(p, v, __ATOMIC_RELAXED, __HIP_MEMORY_SCOPE_AGENT); }
__device__ __forceinline__ unsigned xb_xcc_id() { return (unsigned)__builtin_amdgcn_s_getreg((3 << 11) | 20) & 0xFu; }
#define XB_SPIN(cond, bar) do { unsigned _sp = 0; while (cond) { __builtin_amdgcn_s_sleep(1); \
    if ((++_sp & 255u) == 0u) { if (xb_ld(&(bar)[XB_TMO])) break; if (_sp > XB_SPIN_CAP) { atomicAdd(&(bar)[XB_TMO], 1u); break; } } } } while (0)
struct XcdBarrier { unsigned* bar; unsigned x; volatile LAS unsigned* st; };
__device__ __forceinline__ XcdBarrier xcd_barrier_post(unsigned* bar, volatile LAS unsigned* st) {
    XcdBarrier b; b.bar = bar; b.x = xb_xcc_id(); b.st = st;
    if (threadIdx.x == 0) (void)xb_add(&bar[XB_XCNT(b.x)], 1u);
    return b;
}
__device__ __forceinline__ void xcd_barrier_complete(unsigned* bar, unsigned x, unsigned& nloc, unsigned& nx) {
    const unsigned G = gridDim.x * gridDim.y * gridDim.z;
    unsigned sum, cnt, mine, sp = 0u;
    for (;;) {
        sum = 0u; cnt = 0u; mine = 0u;
#pragma unroll
        for (unsigned j = 0; j < 16; ++j) { const unsigned c = xb_ld(&bar[XB_XCNT(j)]); sum += c; cnt += (c > 0u) ? 1u : 0u; mine = (j == x) ? c : mine; }
        if (sum == G) break;
        __builtin_amdgcn_s_sleep(1);
        if ((++sp & 255u) == 0u) { if (xb_ld(&bar[XB_TMO])) break; if (sp > XB_SPIN_CAP) { atomicAdd(&bar[XB_TMO], 1u); break; } }
    }
    nloc = mine > 0u ? mine : 1u; nx = cnt > 0u ? cnt : 1u;
}
__device__ __forceinline__ void xcd_barrier(const XcdBarrier& b) {
    asm volatile("s_waitcnt vmcnt(0)" ::: "memory");
    __syncthreads();
    if (threadIdx.x == 0) {
        unsigned* bar = b.bar;
        __builtin_amdgcn_s_waitcnt(0);
        unsigned nloc = b.st[0], nx = b.st[1];
        if (nloc == 0u) { xcd_barrier_complete(bar, b.x, nloc, nx); b.st[0] = nloc; b.st[1] = nx; }
        const unsigned old = xb_add(&bar[XB_XSUB(b.x)], 1u);
        const unsigned gen = old / nloc;
        if (old + 1u == (gen + 1u) * nloc) {
            __builtin_amdgcn_fence(__ATOMIC_RELEASE, "agent");
            asm volatile("s_waitcnt vmcnt(0)" ::: "memory");
            const unsigned og = xb_add(&bar[XB_TOP], 1u);
            const unsigned tg = og / nx;
            if (og + 1u == (tg + 1u) * nx) xb_add(&bar[XB_TOPGEN], 1u);
            else XB_SPIN(xb_ld(&bar[XB_TOPGEN]) == tg, bar);
            __builtin_amdgcn_fence(__ATOMIC_ACQUIRE, "agent");
            xb_add(&bar[XB_XGEN(b.x)], 1u);
            asm volatile("s_waitcnt vmcnt(0)" ::: "memory");
        } else {
            XB_SPIN(xb_ld(&bar[XB_XGEN(b.x)]) == gen, bar);
            __builtin_amdgcn_fence(__ATOMIC_ACQUIRE, "agent");
            asm volatile("s_waitcnt vmcnt(0)" ::: "memory");
        }
    }
    __syncthreads();
}

template <int WR, int WC>
__device__ __forceinline__ void gemm_acc(f32x4 (&acc)[4][4], const bf16_t* __restrict__ A, int lda, const bf16_t* __restrict__ Bt, int ldb,
                                         int K, int row0, int col0, char* lds) {
    constexpr int BM = 64 * WR, BN = 64 * WC, STAGE = (BM + BN) * 128;
    static_assert(BM / 64 + BN / 64 == 6, "vmcnt(6) below assumes 6 LDS-DMA loads per thread per K-tile");
    const int tid = threadIdx.x, lane = tid & 63, wid = tid >> 6;
    const int wr = wid / WC, wc = wid % WC, fr = lane & 15, fq = lane >> 4;
    const int nk = K >> 6;
    const int sr = tid >> 3, sp = tid & 7;
    const int sc = sp ^ ((sr >> 1) & 7);
    const bf16_t* ga = A + (size_t)(row0 + sr) * lda + sc * 8;
    const bf16_t* gb = Bt + (size_t)(col0 + sr) * ldb + sc * 8;
    auto stage = [&](int kt, int buf) {
        char* base = lds + buf * STAGE + tid * 16;
#pragma unroll
        for (int i = 0; i < BM / 64; ++i) gl_lds16(ga + (size_t)i * 64 * lda + kt * 64, base + i * 8192);
#pragma unroll
        for (int i = 0; i < BN / 64; ++i) gl_lds16(gb + (size_t)i * 64 * ldb + kt * 64, base + BM * 128 + i * 8192);
    };
    stage(0, 0);
    if (nk > 1) stage(1, 1);
    const int swz = fr >> 1;
    int buf = 0;
#pragma unroll 1
    for (int kt = 0; kt < nk; ++kt) {
        if (kt + 1 < nk) asm volatile("s_waitcnt vmcnt(6)" ::: "memory");
        else             asm volatile("s_waitcnt vmcnt(0)" ::: "memory");
        __builtin_amdgcn_s_barrier();
        asm volatile("" ::: "memory");
        if (kt + 2 < nk) { int b2 = buf + 2; if (b2 >= 3) b2 -= 3; stage(kt + 2, b2); }
        const char* sa = lds + buf * STAGE;
        const char* sb = sa + BM * 128;
#pragma unroll
        for (int ks = 0; ks < 2; ++ks) {
            bf16x8 af[4], bfr[4];
            const int pos = ((ks * 4 + fq) ^ swz) * 16;
#pragma unroll
            for (int mi = 0; mi < 4; ++mi) af[mi] = *(const bf16x8*)(sa + (wr * 64 + mi * 16 + fr) * 128 + pos);
#pragma unroll
            for (int ni = 0; ni < 4; ++ni) bfr[ni] = *(const bf16x8*)(sb + (wc * 64 + ni * 16 + fr) * 128 + pos);
#pragma unroll
            for (int mi = 0; mi < 4; ++mi)
#pragma unroll
                for (int ni = 0; ni < 4; ++ni)
                    acc[mi][ni] = __builtin_amdgcn_mfma_f32_16x16x32_bf16(bfr[ni], af[mi], acc[mi][ni], 0, 0, 0);
        }
        buf = (buf == 2) ? 0 : buf + 1;
    }
    __syncthreads();
}
template <int WR, int WC, class F>
__device__ __forceinline__ void gemm_epi(const f32x4 (&acc)[4][4], int row0, int col0, F f) {
    const int lane = threadIdx.x & 63, wid = threadIdx.x >> 6;
    const int wr = wid / WC, wc = wid % WC, fr = lane & 15, fq = lane >> 4;
#pragma unroll
    for (int mi = 0; mi < 4; ++mi) {
#pragma unroll
        for (int ni = 0; ni < 4; ++ni)
            f(row0 + wr * 64 + mi * 16 + fr, col0 + wc * 64 + ni * 16 + fq * 4, acc[mi][ni]);
        __builtin_amdgcn_sched_barrier(0);
    }
}
__device__ __forceinline__ void zero_acc(f32x4 (&acc)[4][4]) {
#pragma unroll
    for (int i = 0; i < 4; ++i)
#pragma unroll
        for (int j = 0; j < 4; ++j) acc[i][j] = (f32x4){0.f, 0.f, 0.f, 0.f};
}

__device__ __forceinline__ void s5_disc(const Params& p, int g, int pi, float& lbr, float& lbi, float& cr, float& ci) {
    const float dt = expf(p.in[9][g]);
    const float lr = p.in[7][g * 64 + pi], li = p.in[8][g * 64 + pi];
    const float mag = expf(lr * dt), ang = li * dt;
    float s, c; sincosf(ang, &s, &c);
    lbr = mag * c; lbi = mag * s;
    const float den = lr * lr + li * li, nr = lbr - 1.f;
    cr = (nr * lr + lbi * li) / den;
    ci = (lbi * lr - nr * li) / den;
}

__device__ void s5_tables(const Params& p, int g, char* lds) {
    float* Cre = (float*)lds;
    float* Cim = Cre + 1024;
    float* Gre = Cim + 1024;
    float* Gim = Gre + 1024;
    const int tid = threadIdx.x;
    bf16_t* BtE = (bf16_t*)(p.ws + OFF_BTE) + (size_t)g * 128 * 256;
    bf16_t* BtY = (bf16_t*)(p.ws + OFF_BTY) + (size_t)g * 256 * 384;
    float lr_[2], li_[2], gr[2], gi[2];
#pragma unroll
    for (int h = 0; h < 2; ++h) {
        const int q = tid + 512 * h, pi = q >> 4, ci = q & 15;
        float cr, cim; s5_disc(p, g, pi, lr_[h], li_[h], cr, cim);
        const float br = p.in[10][(g * 64 + pi) * 16 + ci], bi = p.in[11][(g * 64 + pi) * 16 + ci];
        gr[h] = cr * br - cim * bi; gi[h] = cr * bi + cim * br;
        Cre[q] = p.in[12][g * 1024 + q]; Cim[q] = p.in[13][g * 1024 + q];
        float er = gr[h], ei = gi[h];
        for (int j = 15; j >= 0; --j) {
            BtE[(2 * pi) * 256 + j * 16 + ci] = f2bf(er);
            BtE[(2 * pi + 1) * 256 + j * 16 + ci] = f2bf(ei);
            const float nr = er * lr_[h] - ei * li_[h], ni = er * li_[h] + ei * lr_[h]; er = nr; ei = ni;
        }
    }
#pragma unroll
    for (int h = 0; h < 2; ++h) {
        const int q = tid + 512 * h, co = q >> 6, pi = q & 63;
        float lr, li, cr, cim; s5_disc(p, g, pi, lr, li, cr, cim);
        const float c_r = p.in[12][(g * 16 + co) * 64 + pi], c_i = p.in[13][(g * 16 + co) * 64 + pi];
        float qr = c_r * lr - c_i * li, qi = c_r * li + c_i * lr;
        for (int t = 0; t < 16; ++t) {
            *(unsigned*)(BtY + (size_t)(t * 16 + co) * 384 + 256 + 2 * pi) = cvt_pk_bf16(qr, -qi);
            const float nr = qr * lr - qi * li, ni = qr * li + qi * lr; qr = nr; qi = ni;
        }
    }
    for (int k = 0; k < 16; ++k) {
        __syncthreads();
#pragma unroll
        for (int h = 0; h < 2; ++h) { const int q = tid + 512 * h; Gre[q] = gr[h]; Gim[q] = gi[h]; }
        __syncthreads();
        if (tid < 256) {
            const int co = tid >> 4, ci = tid & 15;
            float s = 0.f;
#pragma unroll 8
            for (int pi = 0; pi < 64; ++pi) s += Cre[co * 64 + pi] * Gre[pi * 16 + ci] - Cim[co * 64 + pi] * Gim[pi * 16 + ci];
            if (k == 0 && co == ci) s += p.in[14][g * 16 + co];
            const bf16_t v = f2bf(s);
            for (int t = k; t < 16; ++t) BtY[(size_t)(t * 16 + co) * 384 + (t - k) * 16 + ci] = v;
        } else if (k >= 1) {
            const int co = (tid - 256) >> 4, ci = tid & 15;
            for (int t = 0; t + k < 16; ++t) BtY[(size_t)(t * 16 + co) * 384 + (t + k) * 16 + ci] = 0;
        }
#pragma unroll
        for (int h = 0; h < 2; ++h) { const float nr = gr[h] * lr_[h] - gi[h] * li_[h], ni = gr[h] * li_[h] + gi[h] * lr_[h]; gr[h] = nr; gi[h] = ni; }
    }
    __syncthreads();
}

__device__ void transpose_tile(const float* __restrict__ src, int ldn, bf16_t* __restrict__ dst, int ldk, int k0, int n0, char* lds) {
    float* tile = (float*)lds;
    const int tid = threadIdx.x;
#pragma unroll
    for (int ps = 0; ps < 2; ++ps) {
        const int k = (tid >> 4) + ps * 32, n4 = (tid & 15) * 4;
        const f32x4 v = *(const f32x4*)(src + (size_t)(k0 + k) * ldn + n0 + n4);
        tile[k * 65 + n4 + 0] = v[0]; tile[k * 65 + n4 + 1] = v[1]; tile[k * 65 + n4 + 2] = v[2]; tile[k * 65 + n4 + 3] = v[3];
    }
    __syncthreads();
    {
        const int n = tid >> 3, kc = (tid & 7) * 8;
        u32x4 o;
        o[0] = cvt_pk_bf16(tile[(kc + 0) * 65 + n], tile[(kc + 1) * 65 + n]);
        o[1] = cvt_pk_bf16(tile[(kc + 2) * 65 + n], tile[(kc + 3) * 65 + n]);
        o[2] = cvt_pk_bf16(tile[(kc + 4) * 65 + n], tile[(kc + 5) * 65 + n]);
        o[3] = cvt_pk_bf16(tile[(kc + 6) * 65 + n], tile[(kc + 7) * 65 + n]);
        *(u32x4*)(dst + (size_t)(n0 + n) * ldk + k0 + kc) = o;
    }
    __syncthreads();
}

__device__ void phase_prep(const Params& p, char* lds) {
    const int tid = threadIdx.x, lane = tid & 63, wid = tid >> 6;
    constexpr int N_TAB = 32, N_TR = 1280 + 64 + 128 + 256 + 256 + 32, N_ROW = NTOK / 8;
    for (int item = blockIdx.x; item < N_TAB + N_TR + N_ROW; item += gridDim.x) {
        if (item < N_TAB) { s5_tables(p, item, lds); continue; }
        int t = item - N_TAB;
        if (t < N_TR) {
            if (t < 1280) { transpose_tile(p.in[6], 5120, (bf16_t*)(p.ws + OFF_WTIN), 1024, (t / 80) * 64, (t % 80) * 64, lds); continue; }
            t -= 1280;
            if (t < 64) { transpose_tile(p.in[15], 512, (bf16_t*)(p.ws + OFF_WTGLU), 512, (t / 8) * 64, (t % 8) * 64, lds); continue; }
            t -= 64;
            if (t < 128) { transpose_tile(p.in[24], 1024, (bf16_t*)(p.ws + OFF_WTPA), 512, (t / 16) * 64, (t % 16) * 64, lds); continue; }
            t -= 128;
            if (t < 256) { transpose_tile(p.in[25], 1024, (bf16_t*)(p.ws + OFF_WTPB), 1024, (t / 16) * 64, (t % 16) * 64, lds); continue; }
            t -= 256;
            if (t < 256) { transpose_tile(p.in[26], 1024, (bf16_t*)(p.ws + OFF_WTOUT), 1024, (t / 16) * 64, (t % 16) * 64, lds); continue; }
            t -= 256;
            { const int hd = t >> 1, which = t & 1;
              transpose_tile(p.in[which ? 21 : 19] + hd * 4096, 64, (bf16_t*)(p.ws + OFF_WTG) + (hd * 128 + which * 64) * 64, 64, 0, 0, lds); continue; }
        }
        t -= N_TR;
        {
            const int tok = t * 8 + wid;
            const float* x = xrow(p, tok) + lane * 16;
            f32x4 v[4]; float ss = 0.f;
#pragma unroll
            for (int i = 0; i < 4; ++i) { v[i] = *(const f32x4*)(x + i * 4); ss += v[i][0] * v[i][0] + v[i][1] * v[i][1] + v[i][2] * v[i][2] + v[i][3] * v[i][3]; }
#pragma unroll
            for (int o = 32; o; o >>= 1) ss += __shfl_xor(ss, o);
            const float rs = rsqrtf(ss * (1.f / 1024.f) + 1e-6f);
            const float* gp = p.in[5] + lane * 16;
            u32x4 o0, o1;
            { const f32x4 g0 = *(const f32x4*)(gp), g1 = *(const f32x4*)(gp + 4), g2 = *(const f32x4*)(gp + 8), g3 = *(const f32x4*)(gp + 12);
              o0[0] = cvt_pk_bf16(v[0][0] * rs * g0[0], v[0][1] * rs * g0[1]); o0[1] = cvt_pk_bf16(v[0][2] * rs * g0[2], v[0][3] * rs * g0[3]);
              o0[2] = cvt_pk_bf16(v[1][0] * rs * g1[0], v[1][1] * rs * g1[1]); o0[3] = cvt_pk_bf16(v[1][2] * rs * g1[2], v[1][3] * rs * g1[3]);
              o1[0] = cvt_pk_bf16(v[2][0] * rs * g2[0], v[2][1] * rs * g2[1]); o1[1] = cvt_pk_bf16(v[2][2] * rs * g2[2], v[2][3] * rs * g2[3]);
              o1[2] = cvt_pk_bf16(v[3][0] * rs * g3[0], v[3][1] * rs * g3[1]); o1[3] = cvt_pk_bf16(v[3][2] * rs * g3[2], v[3][3] * rs * g3[3]); }
            bf16_t* xn = (bf16_t*)(p.ws + OFF_REGA) + (size_t)tok * 1024 + lane * 16;
            *(u32x4*)xn = o0; *(u32x4*)(xn + 8) = o1;
        }
    }
}

__device__ void phase_gemm1(const Params& p, char* lds) {
    const bf16_t* xn = (const bf16_t*)(p.ws + OFF_REGA);
    const bf16_t* wt = (const bf16_t*)(p.ws + OFF_WTIN);
    bf16_t* uax = (bf16_t*)(p.ws + OFF_UAX);
    bf16_t* sza = (bf16_t*)(p.ws + OFF_SZA);
    bf16_t* ub  = (bf16_t*)(p.ws + OFF_REGB);
    bf16_t* szb = (bf16_t*)(p.ws + OFF_SZB);
    bf16_t* sg  = (bf16_t*)(p.out + O_Y);
    float* out = p.out;
    constexpr int NMT = NTOK / 128, NNT = 5120 / 256;
    for (int tile = blockIdx.x; tile < NMT * NNT; tile += gridDim.x) {
        const int mt = tile / NNT, nt = tile % NNT, row0 = mt * 128, col0 = nt * 256;
        f32x4 acc[4][4]; zero_acc(acc);
        gemm_acc<2, 4>(acc, xn, 1024, wt, 1024, 1024, row0, col0, lds);
        if (col0 < 512) {
            gemm_epi<2, 4>(acc, row0, col0, [&](int r, int c, const f32x4& v) {
                const int g = c >> 4, co = c & 15, n = r >> 4, t = r & 15;
                u32x2 o; o[0] = cvt_pk_bf16(v[0], v[1]); o[1] = cvt_pk_bf16(v[2], v[3]);
                *(u32x2*)(uax + ((size_t)g * NSUBP + n) * 384 + t * 16 + co) = o; });
        } else if (col0 < 1024) {
            gemm_epi<2, 4>(acc, row0, col0, [&](int r, int c, const f32x4& v) {
                u32x2 o; o[0] = cvt_pk_bf16(silu(v[0]), silu(v[1])); o[1] = cvt_pk_bf16(silu(v[2]), silu(v[3]));
                *(u32x2*)(sza + (size_t)r * 512 + (c - 512)) = o; });
        } else if (col0 < 2048) {
            gemm_epi<2, 4>(acc, row0, col0, [&](int r, int c, const f32x4& v) {
                u32x2 o; o[0] = cvt_pk_bf16(v[0], v[1]); o[1] = cvt_pk_bf16(v[2], v[3]);
                const int ch = c - 1024;
                *(u32x2*)(ub + (size_t)r * 1024 + ch) = o;
                if (r < NPTOK) { const int tau = r & 2047; if (tau >= 2045) *(f32x4*)(out + O_CONVP + ((size_t)(r >> 11) * 3 + (tau - 2045)) * 1024 + ch) = v; }
                else { const int q = r - NPTOK, tau = q & 15; if (tau >= 13) *(f32x4*)(out + O_CONVS + ((size_t)(q >> 4) * 3 + (tau - 13)) * 1024 + ch) = v; } });
        } else if (col0 < 3072) {
            gemm_epi<2, 4>(acc, row0, col0, [&](int r, int c, const f32x4& v) {
                u32x2 o; o[0] = cvt_pk_bf16(silu(v[0]), silu(v[1])); o[1] = cvt_pk_bf16(silu(v[2]), silu(v[3]));
                *(u32x2*)(szb + (size_t)r * 1024 + (c - 2048)) = o; });
        } else {
            gemm_epi<2, 4>(acc, row0, col0, [&](int r, int c, const f32x4& v) {
                u32x2 o; o[0] = cvt_pk_bf16(sigm(v[0]), sigm(v[1])); o[1] = cvt_pk_bf16(sigm(v[2]), sigm(v[3]));
                *(u32x2*)(sg + (size_t)r * 2048 + (c - 3072)) = o; });
        }
    }
}

__device__ void lru_local_item(const Params& p, int tt, int hd, char* lds) {
    const int tid = threadIdx.x, lane = tid & 63, wid = tid >> 6, fr = lane & 15, fq = lane >> 4;
    char* sA = lds;
    float* xg = (float*)(lds + 16384);
    float* af = xg + 128 * 68;
    const bf16_t* ub = (const bf16_t*)(p.ws + OFF_REGB);
#pragma unroll
    for (int ps = 0; ps < 2; ++ps) {
        const int t = (tid >> 3) + ps * 64, c8 = tid & 7, tok = tt * 128 + t, ch0 = hd * 64 + c8 * 8;
        int tau, seq; const bool smp = tok >= NPTOK;
        if (!smp) { tau = tok & 2047; seq = tok >> 11; } else { tau = (tok - NPTOK) & 15; seq = (tok - NPTOK) >> 4; }
        float xc[8];
        { const f32x4 b0 = *(const f32x4*)(p.in[18] + ch0), b1 = *(const f32x4*)(p.in[18] + ch0 + 4);
          xc[0] = b0[0]; xc[1] = b0[1]; xc[2] = b0[2]; xc[3] = b0[3]; xc[4] = b1[0]; xc[5] = b1[1]; xc[6] = b1[2]; xc[7] = b1[3]; }
#pragma unroll
        for (int k = 0; k < 4; ++k) {
            const int st = tau + k - 3;
            float in[8];
            if (st >= 0) {
                const u32x4 w = *(const u32x4*)(ub + (size_t)(tok + k - 3) * 1024 + ch0);
#pragma unroll
                for (int j = 0; j < 4; ++j) { in[2 * j] = bflo(w[j]); in[2 * j + 1] = bfhi(w[j]); }
            } else if (smp) {
                const float* sp = p.in[4] + ((size_t)seq * 3 + (tau + k)) * 1024 + ch0;
                const f32x4 s0 = *(const f32x4*)sp, s1 = *(const f32x4*)(sp + 4);
                in[0] = s0[0]; in[1] = s0[1]; in[2] = s0[2]; in[3] = s0[3]; in[4] = s1[0]; in[5] = s1[1]; in[6] = s1[2]; in[7] = s1[3];
            } else {
#pragma unroll
                for (int j = 0; j < 8; ++j) in[j] = 0.f;
            }
            const f32x4 w0 = *(const f32x4*)(p.in[17] + k * 1024 + ch0), w1 = *(const f32x4*)(p.in[17] + k * 1024 + ch0 + 4);
            xc[0] += w0[0] * in[0]; xc[1] += w0[1] * in[1]; xc[2] += w0[2] * in[2]; xc[3] += w0[3] * in[3];
            xc[4] += w1[0] * in[4]; xc[5] += w1[1] * in[5]; xc[6] += w1[2] * in[6]; xc[7] += w1[3] * in[7];
        }
        u32x4 o; o[0] = cvt_pk_bf16(xc[0], xc[1]); o[1] = cvt_pk_bf16(xc[2], xc[3]); o[2] = cvt_pk_bf16(xc[4], xc[5]); o[3] = cvt_pk_bf16(xc[6], xc[7]);
        *(u32x4*)(sA + t * 128 + ((c8 ^ ((t >> 1) & 7)) * 16)) = o;
        *(f32x4*)(xg + t * 68 + c8 * 8) = (f32x4){xc[0], xc[1], xc[2], xc[3]};
        *(f32x4*)(xg + t * 68 + c8 * 8 + 4) = (f32x4){xc[4], xc[5], xc[6], xc[7]};
    }
    __syncthreads();
    {
        const int cb = wid & 3, th = wid >> 2;
        const bf16_t* wg = (const bf16_t*)(p.ws + OFF_WTG) + (size_t)hd * 128 * 64;
        bf16x8 br[2], bi[2];
#pragma unroll
        for (int ks = 0; ks < 2; ++ks) {
            br[ks] = *(const bf16x8*)(wg + (cb * 16 + fr) * 64 + ks * 32 + fq * 8);
            bi[ks] = *(const bf16x8*)(wg + (64 + cb * 16 + fr) * 64 + ks * 32 + fq * 8);
        }
        const int chl = cb * 16 + fq * 4, ch = hd * 64 + chl;
        const f32x4 ba = *(const f32x4*)(p.in[20] + ch), bx = *(const f32x4*)(p.in[22] + ch), lam = *(const f32x4*)(p.in[23] + ch);
        f32x4 sp8;
#pragma unroll
        for (int j = 0; j < 4; ++j) sp8[j] = 8.f * log1pf(expf(-lam[j]));
#pragma unroll
        for (int mb = 0; mb < 4; ++mb) {
            const int t = th * 64 + mb * 16 + fr;
            f32x4 ar = {0.f, 0.f, 0.f, 0.f}, ai = {0.f, 0.f, 0.f, 0.f};
#pragma unroll
            for (int ks = 0; ks < 2; ++ks) {
                const bf16x8 a = *(const bf16x8*)(sA + t * 128 + (((ks * 4 + fq) ^ ((t >> 1) & 7)) * 16));
                ar = __builtin_amdgcn_mfma_f32_16x16x32_bf16(br[ks], a, ar, 0, 0, 0);
                ai = __builtin_amdgcn_mfma_f32_16x16x32_bf16(bi[ks], a, ai, 0, 0, 0);
            }
            const f32x4 xc = *(const f32x4*)(xg + t * 68 + chl);
            f32x4 av, gv;
#pragma unroll
            for (int j = 0; j < 4; ++j) {
                const float r = sigm(ar[j] + ba[j]), ig = sigm(ai[j] + bx[j]);
                float la = -sp8[j] * r;
                const float a = __expf(la), x2 = 2.f * la;
                const float om = (x2 > -0.1f) ? -x2 * (1.f + x2 * (0.5f + x2 * (0.16666667f + x2 * 0.041666668f))) : 1.f - a * a;
                av[j] = a; gv[j] = sqrtf(fmaxf(om, 0.f)) * ig * xc[j];
            }
            *(f32x4*)(af + t * 68 + chl) = av;
            *(f32x4*)(xg + t * 68 + chl) = gv;
        }
    }
    __syncthreads();
    {
        const int sc = tid >> 6, chl = tid & 63, ch = hd * 64 + chl;
        bf16_t* hl = (bf16_t*)(p.ws + OFF_REGC);
        bf16_t* pb = (bf16_t*)(p.ws + OFF_REGA);
        float h = 0.f, P = 1.f;
#pragma unroll
        for (int s = 0; s < 16; ++s) {
            const int t = sc * 16 + s;
            const float a = af[t * 68 + chl], g = xg[t * 68 + chl];
            h = a * h + g; P *= a;
            const size_t o = (size_t)(tt * 128 + t) * 1024 + ch;
            hl[o] = f2bf(h); pb[o] = f2bf(P);
        }
        const size_t n = (size_t)tt * 8 + sc;
        ((float*)(p.ws + OFF_PEND))[n * 1024 + ch] = P;
        ((float*)(p.ws + OFF_HEND))[n * 1024 + ch] = h;
    }
    __syncthreads();
}

__device__ void phase_m1(const Params& p, char* lds) {
    constexpr int N_SE = 32 * 5, N_LRU = (NTOK / 128) * 16;
    for (int item = blockIdx.x; item < N_SE + N_LRU; item += gridDim.x) {
        if (item < N_SE) {
            const int g = item / 5, mt = item % 5;
            f32x4 acc[4][4]; zero_acc(acc);
            gemm_acc<4, 2>(acc, (const bf16_t*)(p.ws + OFF_UAX) + (size_t)g * NSUBP * 384, 384,
                           (const bf16_t*)(p.ws + OFF_BTE) + (size_t)g * 128 * 256, 256, 256, mt * 256, 0, lds);
            float* se = (float*)(p.ws + OFF_SEND) + (size_t)g * NSUBP * 128;
            gemm_epi<4, 2>(acc, mt * 256, 0, [&](int r, int c, const f32x4& v) { if (r < NSUB) *(f32x4*)(se + (size_t)r * 128 + c) = v; });
        } else {
            const int it = item - N_SE;
            lru_local_item(p, it >> 4, it & 15, lds);
        }
    }
}

__device__ void phase_m2(const Params& p) {
    const int tid = threadIdx.x;
    for (int item = blockIdx.x; item < 240; item += gridDim.x) {
        if (item < 160) {
            const bool prompt = item < 32;
            const int idx = (prompt ? item : item - 32) * 512 + tid;
            const int seq = idx >> 11, g = (idx >> 6) & 31, pi = idx & 63;
            float lr, li, cr, ci; s5_disc(p, g, pi, lr, li, cr, ci);
#pragma unroll
            for (int s = 0; s < 4; ++s) { const float nr = lr * lr - li * li, ni = 2.f * lr * li; lr = nr; li = ni; }
            const int n0 = prompt ? seq * 128 : 1024 + seq, cnt = prompt ? 128 : 1;
            float hr = 0.f, hi = 0.f;
            if (!prompt) { const f32x2 s0 = *(const f32x2*)(p.in[2] + (((size_t)seq * 32 + g) * 64 + pi) * 2); hr = s0[0]; hi = s0[1]; }
            const float* S = (const float*)(p.ws + OFF_SEND) + ((size_t)g * NSUBP + n0) * 128 + 2 * pi;
            bf16_t* H = (bf16_t*)(p.ws + OFF_UAX) + ((size_t)g * NSUBP + n0) * 384 + 256 + 2 * pi;
#pragma unroll 8
            for (int k = 0; k < cnt; ++k) {
                *(unsigned*)(H + (size_t)k * 384) = cvt_pk_bf16(hr, hi);
                const f32x2 s = *(const f32x2*)(S + (size_t)k * 128);
                const float nr = lr * hr - li * hi + s[0], ni = lr * hi + li * hr + s[1]; hr = nr; hi = ni;
            }
            float* o = p.out + (prompt ? O_S5P : O_S5S) + (((size_t)seq * 32 + g) * 64 + pi) * 2;
            *(f32x2*)o = (f32x2){hr, hi};
        } else {
            const bool prompt = item < 176;
            const int idx = (prompt ? item - 160 : item - 176) * 512 + tid;
            const int seq = idx >> 10, ch = idx & 1023;
            const int n0 = prompt ? seq * 128 : 1024 + seq, cnt = prompt ? 128 : 1;
            float h = prompt ? 0.f : p.in[3][(size_t)seq * 1024 + ch];
            const float* Pe = (const float*)(p.ws + OFF_PEND) + (size_t)n0 * 1024 + ch;
            const float* He = (const float*)(p.ws + OFF_HEND) + (size_t)n0 * 1024 + ch;
            float* Hi = (float*)(p.ws + OFF_HIN) + (size_t)n0 * 1024 + ch;
#pragma unroll 8
            for (int k = 0; k < cnt; ++k) {
                Hi[(size_t)k * 1024] = h;
                h = Pe[(size_t)k * 1024] * h + He[(size_t)k * 1024];
            }
            p.out[(prompt ? O_LRUP : O_LRUS) + (size_t)seq * 1024 + ch] = h;
        }
    }
}

__device__ void phase_m3(const Params& p, char* lds) {
    constexpr int N_Y = 32 * 9, N_FIX = NTOK / 8;
    const int tid = threadIdx.x;
    for (int item = blockIdx.x; item < N_Y + N_FIX; item += gridDim.x) {
        if (item < N_Y) {
            const int g = item / 9, mt = item % 9;
            f32x4 acc[4][4]; zero_acc(acc);
            gemm_acc<2, 4>(acc, (const bf16_t*)(p.ws + OFF_UAX) + (size_t)g * NSUBP * 384, 384,
                           (const bf16_t*)(p.ws + OFF_BTY) + (size_t)g * 256 * 384, 384, 384, mt * 128, 0, lds);
            bf16_t* ya = (bf16_t*)(p.ws + OFF_REGB);
            gemm_epi<2, 4>(acc, mt * 128, 0, [&](int r, int c, const f32x4& v) {
                if (r < NSUB) {
                    const int t = c >> 4, co = c & 15;
                    u32x2 o; o[0] = cvt_pk_bf16(gelu_t(v[0]), gelu_t(v[1])); o[1] = cvt_pk_bf16(gelu_t(v[2]), gelu_t(v[3]));
                    *(u32x2*)(ya + ((size_t)r * 16 + t) * 512 + g * 16 + co) = o; } });
        } else {
            const int it = item - N_Y;
#pragma unroll
            for (int h = 0; h < 2; ++h) {
                const int v8 = it * 1024 + h * 512 + tid, tok = v8 >> 7, c0 = (v8 & 127) * 8;
                const size_t o = (size_t)tok * 1024 + c0;
                const u32x4 hl = *(const u32x4*)((const bf16_t*)(p.ws + OFF_REGC) + o);
                const u32x4 pp = *(const u32x4*)((const bf16_t*)(p.ws + OFF_REGA) + o);
                const u32x4 sz = *(const u32x4*)((const bf16_t*)(p.ws + OFF_SZB) + o);
                const float* hin = (const float*)(p.ws + OFF_HIN) + (size_t)(tok >> 4) * 1024 + c0;
                const f32x4 h0 = *(const f32x4*)hin, h1 = *(const f32x4*)(hin + 4);
                u32x4 r;
                r[0] = cvt_pk_bf16((bflo(hl[0]) + bflo(pp[0]) * h0[0]) * bflo(sz[0]), (bfhi(hl[0]) + bfhi(pp[0]) * h0[1]) * bfhi(sz[0]));
                r[1] = cvt_pk_bf16((bflo(hl[1]) + bflo(pp[1]) * h0[2]) * bflo(sz[1]), (bfhi(hl[1]) + bfhi(pp[1]) * h0[3]) * bfhi(sz[1]));
                r[2] = cvt_pk_bf16((bflo(hl[2]) + bflo(pp[2]) * h1[0]) * bflo(sz[2]), (bfhi(hl[2]) + bfhi(pp[2]) * h1[1]) * bfhi(sz[2]));
                r[3] = cvt_pk_bf16((bflo(hl[3]) + bflo(pp[3]) * h1[2]) * bflo(sz[3]), (bfhi(hl[3]) + bfhi(pp[3]) * h1[3]) * bfhi(sz[3]));
                *(u32x4*)((bf16_t*)(p.ws + OFF_REGC) + o) = r;
            }
        }
    }
}

__device__ void phase_g2(const Params& p, char* lds) {
    const bf16_t* ya = (const bf16_t*)(p.ws + OFF_REGB);
    const bf16_t* sza = (const bf16_t*)(p.ws + OFF_SZA);
    bf16_t* va = (bf16_t*)(p.ws + OFF_SEND);
    const float* bg = p.in[16];
    for (int tile = blockIdx.x; tile < (NTOK / 128) * 2; tile += gridDim.x) {
        const int mt = tile >> 1, nt = tile & 1;
        f32x4 acc[4][4]; zero_acc(acc);
        gemm_acc<2, 4>(acc, ya, 512, (const bf16_t*)(p.ws + OFF_WTGLU), 512, 512, mt * 128, nt * 256, lds);
        gemm_epi<2, 4>(acc, mt * 128, nt * 256, [&](int r, int c, const f32x4& v) {
            const u32x2 y = *(const u32x2*)(ya + (size_t)r * 512 + c), z = *(const u32x2*)(sza + (size_t)r * 512 + c);
            const f32x4 b = *(const f32x4*)(bg + c);
            u32x2 o;
            o[0] = cvt_pk_bf16(bflo(y[0]) * sigm(v[0] + b[0]) * bflo(z[0]), bfhi(y[0]) * sigm(v[1] + b[1]) * bfhi(z[0]));
            o[1] = cvt_pk_bf16(bflo(y[1]) * sigm(v[2] + b[2]) * bflo(z[1]), bfhi(y[1]) * sigm(v[3] + b[3]) * bfhi(z[1]));
            *(u32x2*)(va + (size_t)r * 512 + c) = o; });
    }
}

__device__ void phase_g3(const Params& p, char* lds) {
    const bf16_t* va = (const bf16_t*)(p.ws + OFF_SEND);
    const bf16_t* vb = (const bf16_t*)(p.ws + OFF_REGC);
    const bf16_t* sg = (const bf16_t*)(p.out + O_Y);
    bf16_t* m = (bf16_t*)(p.ws + OFF_REGA);
    for (int tile = blockIdx.x; tile < (NTOK / 128) * 4; tile += gridDim.x) {
        const int mt = tile >> 2, nt = tile & 3, row0 = mt * 128, col0 = nt * 256;
        f32x4 acc[4][4]; zero_acc(acc);
        gemm_acc<2, 4>(acc, va, 512, (const bf16_t*)(p.ws + OFF_WTPA), 512, 512, row0, col0, lds);
        f32x4 acc2[4][4]; zero_acc(acc2);
        gemm_acc<2, 4>(acc2, vb, 1024, (const bf16_t*)(p.ws + OFF_WTPB), 1024, 1024, row0, col0, lds);
        {
            const int lane = threadIdx.x & 63, wid = threadIdx.x >> 6, wr = wid / 4, wc = wid % 4, fr = lane & 15, fq = lane >> 4;
#pragma unroll
            for (int mi = 0; mi < 4; ++mi) {
                __builtin_amdgcn_sched_barrier(0);
#pragma unroll
                for (int ni = 0; ni < 4; ++ni) {
                    const int r = row0 + wr * 64 + mi * 16 + fr, c = col0 + wc * 64 + ni * 16 + fq * 4;
                    const u32x2 ga = *(const u32x2*)(sg + (size_t)r * 2048 + c), gb = *(const u32x2*)(sg + (size_t)r * 2048 + 1024 + c);
                    const f32x4 a = acc[mi][ni], b = acc2[mi][ni];
                    u32x2 o;
                    o[0] = cvt_pk_bf16(bflo(ga[0]) * a[0] + bflo(gb[0]) * b[0], bfhi(ga[0]) * a[1] + bfhi(gb[0]) * b[1]);
                    o[1] = cvt_pk_bf16(bflo(ga[1]) * a[2] + bflo(gb[1]) * b[2], bfhi(ga[1]) * a[3] + bfhi(gb[1]) * b[3]);
                    *(u32x2*)(m + (size_t)r * 1024 + c) = o;
                }
            }
        }
    }
}

__device__ void phase_g4(const Params& p, char* lds) {
    const bf16_t* m = (const bf16_t*)(p.ws + OFF_REGA);
    float* y = p.out + O_Y;
    for (int tile = blockIdx.x; tile < (NTOK / 128) * 4; tile += gridDim.x) {
        const int mt = tile >> 2, nt = tile & 3;
        f32x4 acc[4][4]; zero_acc(acc);
        gemm_acc<2, 4>(acc, m, 1024, (const bf16_t*)(p.ws + OFF_WTOUT), 1024, 1024, mt * 128, nt * 256, lds);
        gemm_epi<2, 4>(acc, mt * 128, nt * 256, [&](int r, int c, const f32x4& v) {
            const f32x4 x = *(const f32x4*)(xrow(p, r) + c);
            *(f32x4*)(y + (size_t)r * 1024 + c) = x + v; });
    }
}

__device__ void phase_n5(const Params& p) {
    const int lane = threadIdx.x & 63, wid = threadIdx.x >> 6;
    for (int item = blockIdx.x; item < NTOK / 8; item += gridDim.x) {
        const int tok = item * 8 + wid;
        float* y = p.out + O_Y + (size_t)tok * 1024 + lane * 4;
        f32x4 v[4]; float ss = 0.f;
#pragma unroll
        for (int i = 0; i < 4; ++i) { v[i] = *(const f32x4*)(y + i * 256); ss += v[i][0] * v[i][0] + v[i][1] * v[i][1] + v[i][2] * v[i][2] + v[i][3] * v[i][3]; }
#pragma unroll
        for (int o = 32; o; o >>= 1) ss += __shfl_xor(ss, o);
        const float rs = rsqrtf(ss * (1.f / 1024.f) + 1e-6f);
#pragma unroll
        for (int i = 0; i < 4; ++i) { const f32x4 g = *(const f32x4*)(p.in[27] + lane * 4 + i * 256); *(f32x4*)(y + i * 256) = v[i] * rs * g; }
    }
}

__device__ __forceinline__ void run_phase(const Params& p, int ph, char* lds) {
    switch (ph) {
        case 0: phase_prep(p, lds); break;
        case 1: phase_gemm1(p, lds); break;
        case 2: phase_m1(p, lds); break;
        case 3: phase_m2(p); break;
        case 4: phase_m3(p, lds); break;
        case 5: phase_g2(p, lds); break;
        case 6: phase_g3(p, lds); break;
        case 7: phase_g4(p, lds); break;
        default: phase_n5(p); break;
    }
}

#if MULTI
template <int PH>
__global__ void __launch_bounds__(NT) phase_kernel(Params p) {
    __shared__ __attribute__((aligned(16))) char lds[LDS_BYTES];
    run_phase(p, PH, lds);
}
#else
__global__ void __launch_bounds__(NT) hybrid_s5_rglru_megakernel(Params p, int use_cg) {
    __shared__ __attribute__((aligned(16))) char lds[LDS_BYTES];
    __shared__ uint4 xbw;
    if (threadIdx.x == 0) xbw = make_uint4(0u, 0u, 0u, 0u);
    __syncthreads();
    XcdBarrier xb = xcd_barrier_post((unsigned*)(p.ws + OFF_BAR), (volatile LAS unsigned*)&xbw);
    if (use_cg) cg::this_grid().sync();
    for (int ph = 0; ph < 9; ++ph) {
        run_phase(p, ph, lds);
        if (ph < 8) xcd_barrier(xb);
    }
}
#endif

extern "C" void kernel_launch(void* const* d_in, const int* in_sizes, int n_in, void* d_out, int out_size, void* d_ws, size_t ws_size,
                              hipStream_t stream) {
    Params p{};
    for (int i = 0; i < 28; ++i) p.in[i] = (const float*)d_in[i];
    p.out = (float*)d_out; p.ws = (char*)d_ws;
#if MULTI
    phase_kernel<0><<<256, NT, 0, stream>>>(p);
    phase_kernel<1><<<256, NT, 0, stream>>>(p);
    phase_kernel<2><<<256, NT, 0, stream>>>(p);
    phase_kernel<3><<<256, NT, 0, stream>>>(p);
    phase_kernel<4><<<256, NT, 0, stream>>>(p);
    phase_kernel<5><<<256, NT, 0, stream>>>(p);
    phase_kernel<6><<<256, NT, 0, stream>>>(p);
    phase_kernel<7><<<256, NT, 0, stream>>>(p);
    phase_kernel<8><<<256, NT, 0, stream>>>(p);
#else
    static int grid_blocks = 0;
    if (!grid_blocks) {
        int dev = 0, cus = 0, per_cu = 0;
        hipGetDevice(&dev);
        hipDeviceGetAttribute(&cus, hipDeviceAttributeMultiprocessorCount, dev);
        hipOccupancyMaxActiveBlocksPerMultiprocessor(&per_cu, hybrid_s5_rglru_megakernel, NT, 0);
        if (per_cu > 1) per_cu = 1;
        grid_blocks = cus * (per_cu > 0 ? per_cu : 1);
    }
    hipMemsetAsync(d_ws, 0, 16384, stream);
    int use_cg = 0;
    void* args[] = {&p, &use_cg};
    hipError_t e = hipLaunchCooperativeKernel((void*)hybrid_s5_rglru_megakernel, dim3(grid_blocks), dim3(NT), args, 0, stream);
    if (e != hipSuccess) fprintf(stderr, "cooperative launch failed: %s (grid %d)\n", hipGetErrorString(e), grid_blocks);
#endif
}
```

```cpp
#include <hip/hip_runtime.h>
#include <hip/hip_cooperative_groups.h>
#include <stdint.h>
#include <cstdio>
namespace cg = cooperative_groups;

#ifndef MULTI
#define MULTI 0
#endif

typedef unsigned short bf16_t;
typedef short bf16x8 __attribute__((ext_vector_type(8)));
typedef float f32x4 __attribute__((ext_vector_type(4)));
typedef float f32x2 __attribute__((ext_vector_type(2)));
typedef unsigned u32x4 __attribute__((ext_vector_type(4)));
typedef unsigned u32x2 __attribute__((ext_vector_type(2)));

#define NT 512
constexpr int NTOK = 16896, NPTOK = 16384;
constexpr int NSUB = 1056, NSUBP = 1280;
constexpr int LDS_BYTES = 147456;

struct Params { const float* in[28]; float* out; char* ws; };

constexpr size_t OFF_BAR   = 0;
constexpr size_t OFF_WTIN  = 16384;
constexpr size_t OFF_WTGLU = OFF_WTIN  + 5120ull * 1024 * 2;
constexpr size_t OFF_WTPA  = OFF_WTGLU + 512ull * 512 * 2;
constexpr size_t OFF_WTPB  = OFF_WTPA  + 1024ull * 512 * 2;
constexpr size_t OFF_WTOUT = OFF_WTPB  + 1024ull * 1024 * 2;
constexpr size_t OFF_WTG   = OFF_WTOUT + 1024ull * 1024 * 2;
constexpr size_t OFF_BTE   = OFF_WTG   + 16ull * 128 * 64 * 2;
constexpr size_t OFF_BTY   = OFF_BTE   + 32ull * 128 * 256 * 2;
constexpr size_t OFF_UAX   = OFF_BTY   + 32ull * 256 * 384 * 2;
constexpr size_t OFF_SZA   = OFF_UAX   + 32ull * NSUBP * 384 * 2;
constexpr size_t OFF_REGA  = OFF_SZA   + (size_t)NTOK * 512 * 2;
constexpr size_t OFF_REGB  = OFF_REGA  + (size_t)NTOK * 1024 * 2;
constexpr size_t OFF_REGC  = OFF_REGB  + (size_t)NTOK * 1024 * 2;
constexpr size_t OFF_SZB   = OFF_REGC  + (size_t)NTOK * 1024 * 2;
constexpr size_t OFF_SEND  = OFF_SZB   + (size_t)NTOK * 1024 * 2;
constexpr size_t OFF_PEND  = OFF_SEND  + 32ull * NSUBP * 128 * 4;
constexpr size_t OFF_HEND  = OFF_PEND  + (size_t)NSUB * 1024 * 4;
constexpr size_t OFF_HIN   = OFF_HEND  + (size_t)NSUB * 1024 * 4;
constexpr size_t WS_TOTAL  = OFF_HIN   + (size_t)NSUB * 1024 * 4;

constexpr size_t O_Y = 0;
constexpr size_t O_S5P = 17301504, O_LRUP = 17334272, O_CONVP = 17342464;
constexpr size_t O_S5S = 17367040, O_LRUS = 17498112, O_CONVS = 17530880;

typedef __bf16 bf16x2_t __attribute__((ext_vector_type(2)));
__device__ __forceinline__ unsigned cvt_pk_bf16(float lo, float hi) {
    const f32x2 v = {lo, hi};
    const bf16x2_t b = __builtin_convertvector(v, bf16x2_t);
    return __builtin_bit_cast(unsigned, b);
}
__device__ __forceinline__ bf16_t f2bf(float f) { return (bf16_t)(cvt_pk_bf16(f, 0.f) & 0xffffu); }
__device__ __forceinline__ float bf2f(unsigned b) { return __uint_as_float(b << 16); }
__device__ __forceinline__ float bflo(unsigned w) { return __uint_as_float(w << 16); }
__device__ __forceinline__ float bfhi(unsigned w) { return __uint_as_float(w & 0xffff0000u); }
__device__ __forceinline__ float sigm(float x) { return __builtin_amdgcn_rcpf(1.f + __expf(-x)); }
__device__ __forceinline__ float silu(float x) { return x * sigm(x); }
__device__ __forceinline__ float gelu_t(float x) { return x * sigm(1.5957691216f * (x + 0.044715f * x * x * x)); }
__device__ __forceinline__ const float* xrow(const Params& p, int tok) {
    return tok < NPTOK ? p.in[0] + (size_t)tok * 1024 : p.in[1] + (size_t)(tok - NPTOK) * 1024;
}
__device__ __forceinline__ void glds16_asm(const void* gsrc, unsigned lds_dst) {
    unsigned keep;
    asm volatile("s_mov_b32 %0, m0\n\ts_mov_b32 m0, %2\n\ts_nop 0\n\tglobal_load_lds_dwordx4 %1, off\n\ts_mov_b32 m0, %0"
                 : "=&s"(keep) : "v"(gsrc), "s"(lds_dst) : "memory");
}
__device__ __forceinline__ unsigned lds_addr(const void* p) { return (unsigned)(size_t)(const __attribute__((address_space(3))) char*)p; }

#define XB_TMO      128
#define XB_XCNT(j)  (256  + 64 * (j))
#define XB_XSUB(j)  (1280 + 64 * (j))
#define XB_XGEN(j)  (2304 + 64 * (j))
#define XB_TOP      3328
#define XB_TOPGEN   3392
#define XCD_BAR_WORDS 3456
#define XB_SPIN_CAP (1u << 20)
#define LAS __attribute__((address_space(3)))
__device__ __forceinline__ unsigned xb_ld(unsigned* p)              { return __hip_atomic_load(p, __ATOMIC_RELAXED, __HIP_MEMORY_SCOPE_AGENT); }
__device__ __forceinline__ unsigned xb_add(unsigned* p, unsigned v) { return __hip_atomic_fetch_add(p, v, __ATOMIC_RELAXED, __HIP_MEMORY_SCOPE_AGENT); }
__device__ __forceinline__ unsigned xb_xcc_id() { return (unsigned)__builtin_amdgcn_s_getreg((3 << 11) | 20) & 0xFu; }
#define XB_SPIN(cond, bar) do { unsigned _sp = 0; while (cond) { __builtin_amdgcn_s_sleep(1); \
    if ((++_sp & 255u) == 0u) { if (xb_ld(&(bar)[XB_TMO])) break; if (_sp > XB_SPIN_CAP) { atomicAdd(&(bar)[XB_TMO], 1u); break; } } } } while (0)
struct XcdBarrier { unsigned* bar; unsigned x; volatile LAS unsigned* st; };
__device__ __forceinline__ XcdBarrier xcd_barrier_post(unsigned* bar, volatile LAS unsigned* st) {
    XcdBarrier b; b.bar = bar; b.x = xb_xcc_id(); b.st = st;
    if (threadIdx.x == 0) (void)xb_add(&bar[XB_XCNT(b.x)], 1u);
    return b;
}
__device__ __forceinline__ void xcd_barrier_complete(unsigned* bar, unsigned x, unsigned& nloc, unsigned& nx) {
    const unsigned G = gridDim.x * gridDim.y * gridDim.z;
    unsigned sum, cnt, mine, sp = 0u;
    for (;;) {
        sum = 0u; cnt = 0u; mine = 0u;
#pragma unroll
        for (unsigned j = 0; j < 16; ++j) { const unsigned c = xb_ld(&bar[XB_XCNT(j)]); sum += c; cnt += (c > 0u) ? 1u : 0u; mine = (j == x) ? c : mine; }
        if (sum == G) break;
        __builtin_amdgcn_s_sleep(1);
        if ((++sp & 255u) == 0u) { if (xb_ld(&bar[XB_TMO])) break; if (sp > XB_SPIN_CAP) { atomicAdd(&bar[XB_TMO], 1u); break; } }
    }
    nloc = mine > 0u ? mine : 1u; nx = cnt > 0u ? cnt : 1u;
}
__device__ __forceinline__ void xcd_barrier(const XcdBarrier& b) {
    asm volatile("s_waitcnt vmcnt(0)" ::: "memory");
    __syncthreads();
    if (threadIdx.x == 0) {
        unsigned* bar = b.bar;
        __builtin_amdgcn_s_waitcnt(0);
        unsigned nloc = b.st[0], nx = b.st[1];
        if (nloc == 0u) { xcd_barrier_complete(bar, b.x, nloc, nx); b.st[0] = nloc; b.st[1] = nx; }
        const unsigned old = xb_add(&bar[XB_XSUB(b.x)], 1u);
        const unsigned gen = old / nloc;
        if (old + 1u == (gen + 1u) * nloc) {
            __builtin_amdgcn_fence(__ATOMIC_RELEASE, "agent");
            asm volatile("s_waitcnt vmcnt(0)" ::: "memory");
            const unsigned og = xb_add(&bar[XB_TOP], 1u);
            const unsigned tg = og / nx;
            if (og + 1u == (tg + 1u) * nx) xb_add(&bar[XB_TOPGEN], 1u);
            else XB_SPIN(xb_ld(&bar[XB_TOPGEN]) == tg, bar);
            __builtin_amdgcn_fence(__ATOMIC_ACQUIRE, "agent");
            xb_add(&bar[XB_XGEN(b.x)], 1u);
            asm volatile("s_waitcnt vmcnt(0)" ::: "memory");
        } else {
            XB_SPIN(xb_ld(&bar[XB_XGEN(b.x)]) == gen, bar);
            __builtin_amdgcn_fence(__ATOMIC_ACQUIRE, "agent");
            asm volatile("s_waitcnt vmcnt(0)" ::: "memory");
        }
    }
    __syncthreads();
}

template <int WR, int WC>
__device__ __forceinline__ void gemm_acc(f32x4 (&acc)[4][4], const bf16_t* __restrict__ A, int lda, const bf16_t* __restrict__ Bt, int ldb,
                                         int K, int row0, int col0, char* lds) {
    constexpr int BM = 64 * WR, BN = 64 * WC, STAGE = (BM + BN) * 128;
    static_assert(BM / 64 + BN / 64 == 6, "vmcnt(6) below assumes 6 LDS-DMA loads per thread per K-tile");
    const int tid = threadIdx.x, lane = tid & 63, wid = __builtin_amdgcn_readfirstlane(tid >> 6);
    const int wr = wid / WC, wc = wid % WC, fr = lane & 15, fq = lane >> 4;
    const int nk = K >> 6;
    const int sr = tid >> 3, sp = tid & 7;
    const int sc = sp ^ ((sr >> 1) & 7);
    const bf16_t* ga = A + (size_t)(row0 + sr) * lda + sc * 8;
    const bf16_t* gb = Bt + (size_t)(col0 + sr) * ldb + sc * 8;
    const unsigned ldsw = lds_addr(lds) + (unsigned)wid * 1024u;
    auto stage = [&](int kt, int buf) {
        const unsigned base = ldsw + (unsigned)(buf * STAGE);
#pragma unroll
        for (int i = 0; i < BM / 64; ++i) glds16_asm(ga + (size_t)i * 64 * lda + kt * 64, base + i * 8192);
#pragma unroll
        for (int i = 0; i < BN / 64; ++i) glds16_asm(gb + (size_t)i * 64 * ldb + kt * 64, base + BM * 128 + i * 8192);
    };
    stage(0, 0);
    if (nk > 1) stage(1, 1);
    const int swz = fr >> 1;
    int buf = 0;
#pragma unroll 1
    for (int kt = 0; kt < nk; ++kt) {
        if (kt + 1 < nk) asm volatile("s_waitcnt vmcnt(6)" ::: "memory");
        else             asm volatile("s_waitcnt vmcnt(0)" ::: "memory");
        __builtin_amdgcn_s_barrier();
        asm volatile("" ::: "memory");
        if (kt + 2 < nk) { int b2 = buf + 2; if (b2 >= 3) b2 -= 3; stage(kt + 2, b2); }
        const char* sa = lds + buf * STAGE;
        const char* sb = sa + BM * 128;
#pragma unroll
        for (int ks = 0; ks < 2; ++ks) {
            bf16x8 af[4], bfr[4];
            const int pos = ((ks * 4 + fq) ^ swz) * 16;
#pragma unroll
            for (int mi = 0; mi < 4; ++mi) af[mi] = *(const bf16x8*)(sa + (wr * 64 + mi * 16 + fr) * 128 + pos);
#pragma unroll
            for (int ni = 0; ni < 4; ++ni) bfr[ni] = *(const bf16x8*)(sb + (wc * 64 + ni * 16 + fr) * 128 + pos);
            __builtin_amdgcn_s_setprio(1);
#pragma unroll
            for (int mi = 0; mi < 4; ++mi)
#pragma unroll
                for (int ni = 0; ni < 4; ++ni)
                    acc[mi][ni] = __builtin_amdgcn_mfma_f32_16x16x32_bf16(bfr[ni], af[mi], acc[mi][ni], 0, 0, 0);
            __builtin_amdgcn_s_setprio(0);
        }
        buf = (buf == 2) ? 0 : buf + 1;
    }
    __syncthreads();
}
template <int WR, int WC, class F>
__device__ __forceinline__ void gemm_epi(const f32x4 (&acc)[4][4], int row0, int col0, F f) {
    const int lane = threadIdx.x & 63, wid = __builtin_amdgcn_readfirstlane(threadIdx.x >> 6);
    const int wr = wid / WC, wc = wid % WC, fr = lane & 15, fq = lane >> 4;
#pragma unroll
    for (int mi = 0; mi < 4; ++mi) {
#pragma unroll
        for (int ni = 0; ni < 4; ++ni)
            f(row0 + wr * 64 + mi * 16 + fr, col0 + wc * 64 + ni * 16 + fq * 4, acc[mi][ni]);
        __builtin_amdgcn_sched_barrier(0);
    }
}
__device__ __forceinline__ void zero_acc(f32x4 (&acc)[4][4]) {
#pragma unroll
    for (int i = 0; i < 4; ++i)
#pragma unroll
        for (int j = 0; j < 4; ++j) acc[i][j] = (f32x4){0.f, 0.f, 0.f, 0.f};
}


struct TileOrder {
    int nM, nN, nt, xcd, li, per, lo, hi;
    __device__ __forceinline__ void init(int nM_, int nN_) {
        nM = nM_; nN = nN_; nt = nM * nN; xcd = blockIdx.x & 7; li = blockIdx.x >> 3; per = gridDim.x >> 3;
        const int q = nt / 8, r = nt % 8;
        lo = xcd < r ? xcd * (q + 1) : r * (q + 1) + (xcd - r) * q; hi = lo + (xcd < r ? q + 1 : q);
    }
    __device__ __forceinline__ bool get(int i, int& pm, int& pn) const {
        const int w = lo + i * per + li; if (w >= hi) return false;
        const int nig = 8 * nN, gid = w / nig, fm = gid * 8, gsz = (nM - fm) < 8 ? (nM - fm) : 8;
        pm = fm + (w % nig) % gsz; pn = (w % nig) / gsz; return true;
    }
};

__device__ __forceinline__ void s5_disc(const Params& p, int g, int pi, float& lbr, float& lbi, float& cr, float& ci) {
    const float dt = expf(p.in[9][g]);
    const float lr = p.in[7][g * 64 + pi], li = p.in[8][g * 64 + pi];
    const float mag = expf(lr * dt), ang = li * dt;
    float s, c; sincosf(ang, &s, &c);
    lbr = mag * c; lbi = mag * s;
    const float den = lr * lr + li * li, nr = lbr - 1.f;
    cr = (nr * lr + lbi * li) / den;
    ci = (lbi * lr - nr * li) / den;
}

__device__ void s5_tables(const Params& p, int g, int part, char* lds) {
    float* Cre = (float*)lds;
    float* Cim = Cre + 1024;
    float* Gre = Cim + 1024;
    float* Gim = Gre + 1024;
    const int tid = threadIdx.x;
    bf16_t* BtE = (bf16_t*)(p.ws + OFF_BTE) + (size_t)g * 128 * 256;
    bf16_t* BtY = (bf16_t*)(p.ws + OFF_BTY) + (size_t)g * 256 * 384;
    float lr_[2], li_[2], gr[2], gi[2];
#pragma unroll
    for (int h = 0; h < 2; ++h) {
        const int q = tid + 512 * h, pi = q >> 4, ci = q & 15;
        float cr, cim; s5_disc(p, g, pi, lr_[h], li_[h], cr, cim);
        const float br = p.in[10][(g * 64 + pi) * 16 + ci], bi = p.in[11][(g * 64 + pi) * 16 + ci];
        gr[h] = cr * br - cim * bi; gi[h] = cr * bi + cim * br;
        Cre[q] = p.in[12][g * 1024 + q]; Cim[q] = p.in[13][g * 1024 + q];
        float er = gr[h], ei = gi[h];
        for (int j = 15; j >= 0; --j) {
            if ((j >> 2) == part) {
                BtE[(2 * pi) * 256 + j * 16 + ci] = f2bf(er);
                BtE[(2 * pi + 1) * 256 + j * 16 + ci] = f2bf(ei);
            }
            const float nr = er * lr_[h] - ei * li_[h], ni = er * li_[h] + ei * lr_[h]; er = nr; ei = ni;
        }
    }
#pragma unroll
    for (int h = 0; h < 2; ++h) {
        const int q = tid + 512 * h, co = q >> 6, pi = q & 63;
        float lr, li, cr, cim; s5_disc(p, g, pi, lr, li, cr, cim);
        const float c_r = p.in[12][(g * 16 + co) * 64 + pi], c_i = p.in[13][(g * 16 + co) * 64 + pi];
        float qr = c_r * lr - c_i * li, qi = c_r * li + c_i * lr;
        for (int t = 0; t < 16; ++t) {
            if ((t >> 2) == part) *(unsigned*)(BtY + (size_t)(t * 16 + co) * 384 + 256 + 2 * pi) = cvt_pk_bf16(qr, -qi);
            const float nr = qr * lr - qi * li, ni = qr * li + qi * lr; qr = nr; qi = ni;
        }
    }
    for (int a = 0; a < 4 * part; ++a) {
#pragma unroll
        for (int h = 0; h < 2; ++h) { const float nr = gr[h] * lr_[h] - gi[h] * li_[h], ni = gr[h] * li_[h] + gi[h] * lr_[h]; gr[h] = nr; gi[h] = ni; }
    }
    for (int k = 4 * part; k < 4 * part + 4; ++k) {
        __syncthreads();
#pragma unroll
        for (int h = 0; h < 2; ++h) { const int q = tid + 512 * h; Gre[q] = gr[h]; Gim[q] = gi[h]; }
        __syncthreads();
        if (tid < 256) {
            const int co = tid >> 4, ci = tid & 15;
            float s = 0.f;
#pragma unroll 8
            for (int pi = 0; pi < 64; ++pi) s += Cre[co * 64 + pi] * Gre[pi * 16 + ci] - Cim[co * 64 + pi] * Gim[pi * 16 + ci];
            if (k == 0 && co == ci) s += p.in[14][g * 16 + co];
            const bf16_t v = f2bf(s);
            for (int t = k; t < 16; ++t) BtY[(size_t)(t * 16 + co) * 384 + (t - k) * 16 + ci] = v;
        } else if (k >= 1) {
            const int co = (tid - 256) >> 4, ci = tid & 15;
            for (int t = 0; t + k < 16; ++t) BtY[(size_t)(t * 16 + co) * 384 + (t + k) * 16 + ci] = 0;
        }
#pragma unroll
        for (int h = 0; h < 2; ++h) { const float nr = gr[h] * lr_[h] - gi[h] * li_[h], ni = gr[h] * li_[h] + gi[h] * lr_[h]; gr[h] = nr; gi[h] = ni; }
    }
    __syncthreads();
}

__device__ void transpose_tile(const float* __restrict__ src, int ldn, bf16_t* __restrict__ dst, int ldk, int k0, int n0, char* lds) {
    float* tile = (float*)lds;
    const int tid = threadIdx.x;
#pragma unroll
    for (int ps = 0; ps < 2; ++ps) {
        const int k = (tid >> 4) + ps * 32, n4 = (tid & 15) * 4;
        const f32x4 v = *(const f32x4*)(src + (size_t)(k0 + k) * ldn + n0 + n4);
        tile[k * 65 + n4 + 0] = v[0]; tile[k * 65 + n4 + 1] = v[1]; tile[k * 65 + n4 + 2] = v[2]; tile[k * 65 + n4 + 3] = v[3];
    }
    __syncthreads();
    {
        const int n = tid >> 3, kc = (tid & 7) * 8;
        u32x4 o;
        o[0] = cvt_pk_bf16(tile[(kc + 0) * 65 + n], tile[(kc + 1) * 65 + n]);
        o[1] = cvt_pk_bf16(tile[(kc + 2) * 65 + n], tile[(kc + 3) * 65 + n]);
        o[2] = cvt_pk_bf16(tile[(kc + 4) * 65 + n], tile[(kc + 5) * 65 + n]);
        o[3] = cvt_pk_bf16(tile[(kc + 6) * 65 + n], tile[(kc + 7) * 65 + n]);
        *(u32x4*)(dst + (size_t)(n0 + n) * ldk + k0 + kc) = o;
    }
    __syncthreads();
}

__device__ void transpose_strip(const float* __restrict__ src, int ldn, bf16_t* __restrict__ dst, int ldk, int k0, int n0, char* lds) {
    float* tile = (float*)lds;
    const int tid = threadIdx.x;
    f32x4 v[8];
#pragma unroll
    for (int ps = 0; ps < 8; ++ps) v[ps] = *(const f32x4*)(src + (size_t)(k0 + (tid >> 6) + ps * 8) * ldn + n0 + (tid & 63) * 4);
#pragma unroll
    for (int ps = 0; ps < 8; ++ps) {
        float* t = tile + ((tid >> 6) + ps * 8) * 257 + (tid & 63) * 4;
        t[0] = v[ps][0]; t[1] = v[ps][1]; t[2] = v[ps][2]; t[3] = v[ps][3];
    }
    __syncthreads();
#pragma unroll
    for (int ps = 0; ps < 4; ++ps) {
        const int n = (tid >> 3) + ps * 64, kc = (tid & 7) * 8;
        u32x4 o;
        o[0] = cvt_pk_bf16(tile[(kc + 0) * 257 + n], tile[(kc + 1) * 257 + n]);
        o[1] = cvt_pk_bf16(tile[(kc + 2) * 257 + n], tile[(kc + 3) * 257 + n]);
        o[2] = cvt_pk_bf16(tile[(kc + 4) * 257 + n], tile[(kc + 5) * 257 + n]);
        o[3] = cvt_pk_bf16(tile[(kc + 6) * 257 + n], tile[(kc + 7) * 257 + n]);
        *(u32x4*)(dst + (size_t)(n0 + n) * ldk + k0 + kc) = o;
    }
    __syncthreads();
}

__device__ void phase_prep(const Params& p, char* lds) {
    const int tid = threadIdx.x, lane = tid & 63, wid = __builtin_amdgcn_readfirstlane(tid >> 6);
    constexpr int N_TR = 320, N_ROW = NTOK / 32;
    for (int item = blockIdx.x; item < N_TR + N_ROW; item += gridDim.x) {
        int t = item;
        if (t < N_TR) { transpose_strip(p.in[6], 5120, (bf16_t*)(p.ws + OFF_WTIN), 1024, (t / 20) * 64, (t % 20) * 256, lds); continue; }
#if 0
            if (t < 16) { transpose_strip(p.in[15], 512, (bf16_t*)(p.ws + OFF_WTGLU), 512, (t / 2) * 64, (t % 2) * 256, lds); continue; }
            t -= 16;
            if (t < 32) { transpose_strip(p.in[24], 1024, (bf16_t*)(p.ws + OFF_WTPA), 512, (t / 4) * 64, (t % 4) * 256, lds); continue; }
            t -= 32;
            if (t < 64) { transpose_strip(p.in[25], 1024, (bf16_t*)(p.ws + OFF_WTPB), 1024, (t / 4) * 64, (t % 4) * 256, lds); continue; }
            t -= 64;
            if (t < 64) { transpose_strip(p.in[26], 1024, (bf16_t*)(p.ws + OFF_WTOUT), 1024, (t / 4) * 64, (t % 4) * 256, lds); continue; }
            t -= 64;
#endif
        t -= N_TR;
        {
            const int tok0 = t * 32 + wid * 4;
            f32x4 v[4][4];
#pragma unroll
            for (int rr = 0; rr < 4; ++rr) {
                const float* x = xrow(p, tok0 + rr) + lane * 16;
#pragma unroll
                for (int i = 0; i < 4; ++i) v[rr][i] = *(const f32x4*)(x + i * 4);
            }
            const float* gp = p.in[5] + lane * 16;
            const f32x4 g0 = *(const f32x4*)(gp), g1 = *(const f32x4*)(gp + 4), g2 = *(const f32x4*)(gp + 8), g3 = *(const f32x4*)(gp + 12);
#pragma unroll
            for (int rr = 0; rr < 4; ++rr) {
                float ss = 0.f;
#pragma unroll
                for (int i = 0; i < 4; ++i) ss += v[rr][i][0] * v[rr][i][0] + v[rr][i][1] * v[rr][i][1] + v[rr][i][2] * v[rr][i][2] + v[rr][i][3] * v[rr][i][3];
#pragma unroll
                for (int o = 32; o; o >>= 1) ss += __shfl_xor(ss, o);
                const float rs = rsqrtf(ss * (1.f / 1024.f) + 1e-6f);
                u32x4 o0, o1;
                o0[0] = cvt_pk_bf16(v[rr][0][0] * rs * g0[0], v[rr][0][1] * rs * g0[1]); o0[1] = cvt_pk_bf16(v[rr][0][2] * rs * g0[2], v[rr][0][3] * rs * g0[3]);
                o0[2] = cvt_pk_bf16(v[rr][1][0] * rs * g1[0], v[rr][1][1] * rs * g1[1]); o0[3] = cvt_pk_bf16(v[rr][1][2] * rs * g1[2], v[rr][1][3] * rs * g1[3]);
                o1[0] = cvt_pk_bf16(v[rr][2][0] * rs * g2[0], v[rr][2][1] * rs * g2[1]); o1[1] = cvt_pk_bf16(v[rr][2][2] * rs * g2[2], v[rr][2][3] * rs * g2[3]);
                o1[2] = cvt_pk_bf16(v[rr][3][0] * rs * g3[0], v[rr][3][1] * rs * g3[1]); o1[3] = cvt_pk_bf16(v[rr][3][2] * rs * g3[2], v[rr][3][3] * rs * g3[3]);
                bf16_t* xn = (bf16_t*)(p.ws + OFF_REGA) + (size_t)(tok0 + rr) * 1024 + lane * 16;
                *(u32x4*)xn = o0; *(u32x4*)(xn + 8) = o1;
            }
        }
    }
}

namespace pg8 {
#define PG8_LAS __attribute__((address_space(3)))
typedef unsigned short bf16_t;
typedef short bf16x8 __attribute__((ext_vector_type(8)));
typedef float f32x4 __attribute__((ext_vector_type(4)));
typedef unsigned u32x4 __attribute__((ext_vector_type(4)));
constexpr int BM = 256, BK = 64, HALF = 128, HTB = HALF * BK * 2  , STAGE_BYTES = 8 * HTB, NXCD = 8, WGM = 8;

__host__ __device__ __forceinline__ int lds_byte(int r, int c) { const int st = (r >> 4) * 2 + (c >> 5), rr = r & 15, cc = c & 31, ob = rr * 64 + cc * 2; return st * 1024 + (ob ^ (((ob >> 9) & 1) << 5)); }
__host__ __device__ __forceinline__ void stage_rc(int b, int& R, int& C) { const int st = b / 1024, sb = b % 1024, swz = sb ^ (((sb >> 9) & 1) << 5); R = (st >> 1) * 16 + swz / 64; C = (st & 1) * 32 + (swz % 64) / 2; }
__host__ __device__ __forceinline__ int perm32(int rho) { const int n = rho >> 4, i = rho & 15; return 8 * (i >> 2) + 4 * n + (i & 3); }

struct Unit { int pm, pn; };
struct Gemm { const bf16_t* A; const bf16_t* Bt; int M, N, K; };

struct StaticOrder {
    int nM, nN, nwg, G, c;
    __host__ __device__ void init(int M, int N, int G_, int c_) { nM = M / BM; nN = N / BM; nwg = nM * nN; G = G_; c = c_; }
    __host__ __device__ bool next(int i, Unit& u) const {
        const long L = (long)i * G + c; if (L >= nwg) return false;
        int wgid = (int)L; { const int q = nwg / NXCD, r = nwg % NXCD, xcd = wgid % NXCD, off = wgid / NXCD; wgid = (xcd < r ? xcd * (q + 1) : r * (q + 1) + (xcd - r) * q) + off; }
        const int nig = WGM * nN, gid = wgid / nig, fm = gid * WGM, gsz = (nM - fm) < WGM ? (nM - fm) : WGM;
        u.pm = fm + ((wgid % nig) % gsz); u.pn = (wgid % nig) / gsz; return true;
    }
    __device__ __forceinline__ void a_ready(const Unit&) const {}
    __device__ __forceinline__ void done(const Unit&) const {}
};

template <class Epi, class Sched, bool ALIGN_EPI = false, bool SP2 = false>
__device__ __forceinline__ void gemm_phase(PG8_LAS unsigned char* lds, const Gemm g, const Sched& S, const Epi& E) {
    const int tid = threadIdx.x, wid = __builtin_amdgcn_readfirstlane(tid >> 6), lane = tid & 63, wr = wid >> 2, wc = wid & 3, fr = lane & 15, fq = lane >> 4;
    const int K = g.K, nt = K / BK;
    unsigned voffA[2], voffB[2];
#pragma unroll
    for (int i = 0; i < 2; ++i) { int R, C; stage_rc(tid * 16 + i * 8192, R, C); const int Rb = Epi::PERM ? ((R & ~31) + perm32(R & 31)) : R;
        voffA[i] = (unsigned)(R * K + C) * 2u; voffB[i] = (unsigned)(Rb * K + C) * 2u; }
    const size_t kstep = (size_t)(BK * 2);
    const size_t hstep = (size_t)HALF * K * 2;
    const size_t tstep = 2 * hstep;
    const unsigned ldsw = (unsigned)wid * 1024u;
    const unsigned lds_u32 = (unsigned)(size_t)lds;
    const int aoff = lds_byte(wr * 64 + fr, fq * 8), boff = lds_byte(wc * 32 + fr, fq * 8);
#define PG8_SA(b, h) (((b) * 2 + (h)) * HTB)
#define PG8_SB(b, h) ((4 + (b) * 2 + (h)) * HTB)
#define PG8_STAGE(bufoff, gbase, voff) do { _Pragma("unroll") for (int _i = 0; _i < 2; ++_i) \
        glds16_asm((const char*)(gbase) + (voff)[_i], lds_u32 + (unsigned)(bufoff) + ldsw + (unsigned)(_i * 8192)); } while (0)
#define PG8_LDA(dst, b, h) do { _Pragma("unroll") for (int m = 0; m < 4; ++m) _Pragma("unroll") for (int k = 0; k < 2; ++k) dst[m][k] = *(const PG8_LAS bf16x8*)(lds + PG8_SA(b, h) + aoff + m * 2048 + k * 1024); } while (0)
#define PG8_LDB(dst, b, h) do { _Pragma("unroll") for (int n = 0; n < 2; ++n) _Pragma("unroll") for (int k = 0; k < 2; ++k) dst[n][k] = *(const PG8_LAS bf16x8*)(lds + PG8_SB(b, h) + boff + n * 2048 + k * 1024); } while (0)
#define PG8_MMA(ai, bj, At, Bt) do { __builtin_amdgcn_s_setprio(1); _Pragma("unroll") for (int m = 0; m < 4; ++m) _Pragma("unroll") for (int n = 0; n < 2; ++n) _Pragma("unroll") for (int k = 0; k < 2; ++k) \
        acc[ai][bj][m][n] = __builtin_amdgcn_mfma_f32_16x16x32_bf16(Bt[n][k], At[m][k], acc[ai][bj][m][n], 0, 0, 0); __builtin_amdgcn_s_setprio(0); } while (0)
#define PG8_WAIT_V(n) asm volatile("s_waitcnt vmcnt(" #n ")" ::: "memory")
#define PG8_WAIT_L(n) asm volatile("s_waitcnt lgkmcnt(" #n ")" ::: "memory")
#define PG8_BAR __builtin_amdgcn_s_barrier()
#define PG8_SCHED __builtin_amdgcn_sched_barrier(0)
    Unit cur, nxt; int ui = 0;
    if (!S.next(0, cur)) return;
    f32x4 acc[2][2][4][2];
#pragma unroll
    for (int a = 0; a < 2; ++a)
#pragma unroll
        for (int b = 0; b < 2; ++b)
#pragma unroll
            for (int m = 0; m < 4; ++m)
#pragma unroll
                for (int n = 0; n < 2; ++n) acc[a][b][m][n] = (f32x4){0.f, 0.f, 0.f, 0.f};
    bf16x8 At[4][2], B0[2][2], B1[2][2];
    const char* cA = (const char*)g.A + (size_t)cur.pm * tstep; const char* cB = (const char*)g.Bt + (size_t)cur.pn * tstep;
    S.a_ready(cur);
    if constexpr (SP2) {
        PG8_STAGE(PG8_SB(0, 0), cB, voffB); PG8_STAGE(PG8_SB(0, 1), cB + hstep, voffB); PG8_STAGE(PG8_SA(0, 0), cA, voffA); PG8_STAGE(PG8_SA(0, 1), cA + hstep, voffA);
        if (wr == 1) PG8_BAR;
        PG8_WAIT_V(2); PG8_BAR;
        PG8_STAGE(PG8_SB(1, 0), cB + kstep, voffB); PG8_STAGE(PG8_SA(1, 0), cA + kstep, voffA); PG8_STAGE(PG8_SB(1, 1), cB + hstep + kstep, voffB);
        PG8_WAIT_V(6); PG8_BAR;
    } else {
        PG8_STAGE(PG8_SB(0, 0), cB, voffB); PG8_STAGE(PG8_SA(0, 0), cA, voffA); PG8_STAGE(PG8_SB(0, 1), cB + hstep, voffB); PG8_STAGE(PG8_SA(0, 1), cA + hstep, voffA);
        if (wr == 1) PG8_BAR;
        PG8_WAIT_V(4); PG8_BAR;
        PG8_STAGE(PG8_SB(1, 0), cB + kstep, voffB); PG8_STAGE(PG8_SA(1, 0), cA + kstep, voffA); PG8_STAGE(PG8_SB(1, 1), cB + hstep + kstep, voffB);
        PG8_WAIT_V(6); PG8_BAR;
    }
    for (;;) {
        const bool has_next = S.next(ui + 1, nxt);
        const char* nA = has_next ? (const char*)g.A + (size_t)nxt.pm * tstep : cA; const char* nB = has_next ? (const char*)g.Bt + (size_t)nxt.pn * tstep : cB;
        for (int t = 0; t < nt; t += 2) {
            const bool last = (t == nt - 2);
            const char* a1 = cA + (size_t)(t + 1) * kstep;
            const char* a2 = last ? nA : cA + (size_t)(t + 2) * kstep; const char* b2 = last ? nB : cB + (size_t)(t + 2) * kstep;
            const char* a3 = a2 + kstep; const char* b3 = b2 + kstep;
            if (last && has_next) S.a_ready(nxt);
            if constexpr (SP2) {
            PG8_LDB(B0, 0, 0); PG8_LDB(B1, 0, 1); PG8_SCHED; PG8_LDA(At, 0, 0); PG8_STAGE(PG8_SA(1, 1), a1 + hstep, voffA);
            PG8_WAIT_V(8); PG8_WAIT_L(0); PG8_BAR; PG8_MMA(0, 0, At, B0); PG8_MMA(0, 1, At, B1); PG8_BAR; PG8_SCHED;
            PG8_LDA(At, 0, 1); PG8_STAGE(PG8_SB(0, 0), b2, voffB); PG8_STAGE(PG8_SB(0, 1), b2 + hstep, voffB); PG8_STAGE(PG8_SA(0, 0), a2, voffA);
            PG8_WAIT_V(8); PG8_WAIT_L(0); PG8_BAR; PG8_MMA(1, 0, At, B0); PG8_MMA(1, 1, At, B1); PG8_BAR; PG8_SCHED;
            PG8_LDB(B0, 1, 0); PG8_LDB(B1, 1, 1); PG8_SCHED; PG8_LDA(At, 1, 0); PG8_STAGE(PG8_SA(0, 1), a2 + hstep, voffA);
            PG8_WAIT_V(8); PG8_WAIT_L(0); PG8_BAR; PG8_MMA(0, 0, At, B0); PG8_MMA(0, 1, At, B1); PG8_BAR; PG8_SCHED;
            PG8_LDA(At, 1, 1); PG8_STAGE(PG8_SB(1, 0), b3, voffB); PG8_STAGE(PG8_SB(1, 1), b3 + hstep, voffB); PG8_STAGE(PG8_SA(1, 0), a3, voffA);
            PG8_WAIT_V(8); PG8_WAIT_L(0); PG8_BAR; PG8_MMA(1, 0, At, B0); PG8_MMA(1, 1, At, B1); PG8_BAR; PG8_SCHED;
            } else {
            PG8_LDB(B0, 0, 0); PG8_SCHED; PG8_LDA(At, 0, 0); PG8_STAGE(PG8_SA(1, 1), a1 + hstep, voffA);
            PG8_WAIT_L(8); PG8_BAR; PG8_WAIT_L(0); PG8_MMA(0, 0, At, B0); PG8_BAR; PG8_SCHED;
            PG8_LDB(B1, 0, 1); PG8_STAGE(PG8_SB(0, 0), b2, voffB);
            PG8_BAR; PG8_WAIT_L(0); PG8_MMA(0, 1, At, B1); PG8_BAR;
            PG8_LDA(At, 0, 1); PG8_STAGE(PG8_SA(0, 0), a2, voffA);
            PG8_BAR; PG8_WAIT_L(0); PG8_MMA(1, 0, At, B0); PG8_BAR; PG8_SCHED;
            PG8_STAGE(PG8_SB(0, 1), b2 + hstep, voffB);
            PG8_WAIT_V(6); PG8_BAR; PG8_MMA(1, 1, At, B1); PG8_BAR;
            PG8_LDB(B0, 1, 0); PG8_SCHED; PG8_LDA(At, 1, 0); PG8_STAGE(PG8_SA(0, 1), a2 + hstep, voffA);
            PG8_WAIT_L(8); PG8_BAR; PG8_WAIT_L(0); PG8_MMA(0, 0, At, B0); PG8_BAR; PG8_SCHED;
            PG8_LDB(B1, 1, 1); PG8_STAGE(PG8_SB(1, 0), b3, voffB);
            PG8_BAR; PG8_WAIT_L(0); PG8_MMA(0, 1, At, B1); PG8_BAR;
            PG8_LDA(At, 1, 1); PG8_STAGE(PG8_SA(1, 0), a3, voffA);
            PG8_BAR; PG8_WAIT_L(0); PG8_MMA(1, 0, At, B0); PG8_BAR; PG8_SCHED;
            PG8_STAGE(PG8_SB(1, 1), b3 + hstep, voffB);
            PG8_WAIT_V(6); PG8_BAR; PG8_MMA(1, 1, At, B1); PG8_BAR;
            }
        }
        if constexpr (ALIGN_EPI) { if (wr == 0) PG8_BAR; }
        if constexpr (!Epi::AFTER_DRAIN) { E(acc, cur, wr, wc, fr, fq); S.done(cur); }
        if (!has_next) break;
#pragma unroll
        for (int a = 0; a < 2; ++a)
#pragma unroll
            for (int b = 0; b < 2; ++b)
#pragma unroll
                for (int m = 0; m < 4; ++m)
#pragma unroll
                    for (int n = 0; n < 2; ++n) acc[a][b][m][n] = (f32x4){0.f, 0.f, 0.f, 0.f};
        cur = nxt; cA = nA; cB = nB; ++ui;
        if constexpr (ALIGN_EPI) { if (wr == 1) PG8_BAR; }
    }
    PG8_WAIT_V(0);
    if constexpr (!ALIGN_EPI) { if (wr == 0) PG8_BAR; }
    PG8_BAR;
    if constexpr (Epi::AFTER_DRAIN) { E.fused(acc, cur, wr, wc, fr, fq, lds, wid, lane); S.done(cur); }
#undef PG8_SA
#undef PG8_SB
#undef PG8_STAGE
#undef PG8_LDA
#undef PG8_LDB
#undef PG8_MMA
#undef PG8_WAIT_V
#undef PG8_WAIT_L
#undef PG8_BAR
#undef PG8_SCHED
}
}

template <class F> struct Epi8 {
    static constexpr bool PERM = true, AFTER_DRAIN = false; F f;
    __device__ __forceinline__ void operator()(const f32x4 (&acc)[2][2][4][2], const pg8::Unit& u, int wr, int wc, int fr, int fq) const {
        const int row0 = u.pm * 256 + wr * 64 + fr, col0 = u.pn * 256 + wc * 32 + 8 * fq;
#pragma unroll
        for (int ai = 0; ai < 2; ++ai)
#pragma unroll
            for (int m = 0; m < 4; ++m) {
#pragma unroll
                for (int bj = 0; bj < 2; ++bj) { f(row0 + ai * 128 + m * 16, col0 + bj * 128, acc[ai][bj][m][0], acc[ai][bj][m][1]); __builtin_amdgcn_sched_barrier(0); }
            }
    }
};
template <class F> struct Epi4 {
    static constexpr bool PERM = false, AFTER_DRAIN = false; F f;
    __device__ __forceinline__ void operator()(const f32x4 (&acc)[2][2][4][2], const pg8::Unit& u, int wr, int wc, int fr, int fq) const {
        const int row0 = u.pm * 256 + wr * 64 + fr, col0 = u.pn * 256 + wc * 32 + 4 * fq;
#pragma unroll
        for (int ai = 0; ai < 2; ++ai)
#pragma unroll
            for (int m = 0; m < 4; ++m) {
#pragma unroll
                for (int bj = 0; bj < 2; ++bj)
#pragma unroll
                    for (int n = 0; n < 2; ++n) f(row0 + ai * 128 + m * 16, col0 + bj * 128 + n * 16, acc[ai][bj][m][n]);
                __builtin_amdgcn_sched_barrier(0);
            }
    }
};
template <class E> __device__ __forceinline__ void run_gemm256(char* lds, const bf16_t* A, const bf16_t* Bt, int M, int N, int K, const E& e, int cshift = 0) {
    pg8::Gemm g{A, Bt, M, N, K};
    pg8::StaticOrder S; S.init(M, N, (int)gridDim.x, (int)((blockIdx.x + gridDim.x - cshift) % gridDim.x));
    pg8::gemm_phase<E, pg8::StaticOrder, !E::AFTER_DRAIN, true>((PG8_LAS unsigned char*)lds, g, S, e);
}
__device__ __forceinline__ u32x4 pack8(const f32x4& a, const f32x4& b) {
    u32x4 o; o[0] = cvt_pk_bf16(a[0], a[1]); o[1] = cvt_pk_bf16(a[2], a[3]); o[2] = cvt_pk_bf16(b[0], b[1]); o[3] = cvt_pk_bf16(b[2], b[3]); return o;
}

struct EpiG1 {
    static constexpr bool PERM = true, AFTER_DRAIN = false;
    bf16_t *uax, *sza, *ub, *szb, *sg; float* out;
    __device__ __forceinline__ void operator()(const f32x4 (&acc)[2][2][4][2], const pg8::Unit& u, int wr, int wc, int fr, int fq) const {
        const int row0 = u.pm * 256 + wr * 64 + fr, col0 = u.pn * 256 + wc * 32 + 8 * fq, colt = u.pn * 256;
#pragma unroll
        for (int ai = 0; ai < 2; ++ai)
#pragma unroll
            for (int m = 0; m < 4; ++m) {
                const int r = row0 + ai * 128 + m * 16;
#pragma unroll
                for (int bj = 0; bj < 2; ++bj) {
                    const int c = col0 + bj * 128;
                    const f32x4 v0 = acc[ai][bj][m][0], v1 = acc[ai][bj][m][1];
                    if (colt < 512) {
                        const int g = c >> 4, co = c & 15, n = r >> 4, t = r & 15;
                        *(u32x4*)(uax + ((size_t)g * NSUBP + n) * 384 + t * 16 + co) = pack8(v0, v1);
                    } else if (colt < 1024) {
                        f32x4 a, b;
#pragma unroll
                        for (int j = 0; j < 4; ++j) { a[j] = silu(v0[j]); b[j] = silu(v1[j]); }
                        *(u32x4*)(sza + (size_t)r * 512 + (c - 512)) = pack8(a, b);
                    } else if (colt < 2048) {
                        const int ch = c - 1024;
                        *(u32x4*)(ub + (size_t)r * 1024 + ch) = pack8(v0, v1);
                        if (r < NPTOK) { const int tau = r & 2047; if (tau >= 2045) { float* o = out + O_CONVP + ((size_t)(r >> 11) * 3 + (tau - 2045)) * 1024 + ch; *(f32x4*)o = v0; *(f32x4*)(o + 4) = v1; } }
                        else { const int q = r - NPTOK, tau = q & 15; if (tau >= 13) { float* o = out + O_CONVS + ((size_t)(q >> 4) * 3 + (tau - 13)) * 1024 + ch; *(f32x4*)o = v0; *(f32x4*)(o + 4) = v1; } }
                    } else if (colt < 3072) {
                        f32x4 a, b;
#pragma unroll
                        for (int j = 0; j < 4; ++j) { a[j] = silu(v0[j]); b[j] = silu(v1[j]); }
                        *(u32x4*)(szb + (size_t)r * 1024 + (c - 2048)) = pack8(a, b);
                    } else {
                        f32x4 a, b;
#pragma unroll
                        for (int j = 0; j < 4; ++j) { a[j] = sigm(v0[j]); b[j] = sigm(v1[j]); }
                        *(u32x4*)(sg + (size_t)r * 2048 + (c - 3072)) = pack8(a, b);
                    }
                }
                __builtin_amdgcn_sched_barrier(0);
            }
    }
};
__device__ void prep_deferred(const Params& p, char* lds, int first, int nwg) {
    for (int item = (int)blockIdx.x - first; item < 128 + 176 + 32; item += nwg) {
        if (item < 128) { s5_tables(p, item >> 2, item & 3, lds); continue; }
        int t = item - 128;
        if (t < 16) { transpose_strip(p.in[15], 512, (bf16_t*)(p.ws + OFF_WTGLU), 512, (t / 2) * 64, (t % 2) * 256, lds); continue; }
        t -= 16;
        if (t < 32) { transpose_strip(p.in[24], 1024, (bf16_t*)(p.ws + OFF_WTPA), 512, (t / 4) * 64, (t % 4) * 256, lds); continue; }
        t -= 32;
        if (t < 64) { transpose_strip(p.in[25], 1024, (bf16_t*)(p.ws + OFF_WTPB), 1024, (t / 4) * 64, (t % 4) * 256, lds); continue; }
        t -= 64;
        if (t < 64) { transpose_strip(p.in[26], 1024, (bf16_t*)(p.ws + OFF_WTOUT), 1024, (t / 4) * 64, (t % 4) * 256, lds); continue; }
        t -= 64;
        { const int hd = t >> 1, which = t & 1;
          transpose_tile(p.in[which ? 21 : 19] + hd * 4096, 64, (bf16_t*)(p.ws + OFF_WTG) + (hd * 128 + which * 64) * 64, 64, 0, 0, lds); }
    }
}
__device__ void phase_gemm1(const Params& p, char* lds) {
    EpiG1 e{(bf16_t*)(p.ws + OFF_UAX), (bf16_t*)(p.ws + OFF_SZA), (bf16_t*)(p.ws + OFF_REGB), (bf16_t*)(p.ws + OFF_SZB), (bf16_t*)(p.out + O_Y), p.out};
    run_gemm256(lds, (const bf16_t*)(p.ws + OFF_REGA), (const bf16_t*)(p.ws + OFF_WTIN), NTOK, 5120, 1024, e);
    if (blockIdx.x >= 40) prep_deferred(p, lds, 40, (int)gridDim.x - 40);
}

struct LruConsts { bf16x8 br[2], bi[2]; f32x4 ba, bx, sp8; };
__device__ __forceinline__ void lru_load_consts(const Params& p, int hd, LruConsts& c) {
    const int tid = threadIdx.x, lane = tid & 63, wid = __builtin_amdgcn_readfirstlane(tid >> 6), fr = lane & 15, fq = lane >> 4;
    const int cb = wid & 3;
    const bf16_t* wg = (const bf16_t*)(p.ws + OFF_WTG) + (size_t)hd * 128 * 64;
#pragma unroll
    for (int ks = 0; ks < 2; ++ks) {
        c.br[ks] = *(const bf16x8*)(wg + (cb * 16 + fr) * 64 + ks * 32 + fq * 8);
        c.bi[ks] = *(const bf16x8*)(wg + (64 + cb * 16 + fr) * 64 + ks * 32 + fq * 8);
    }
    const int ch = hd * 64 + cb * 16 + fq * 4;
    c.ba = *(const f32x4*)(p.in[20] + ch); c.bx = *(const f32x4*)(p.in[22] + ch);
    const f32x4 lam = *(const f32x4*)(p.in[23] + ch);
#pragma unroll
    for (int j = 0; j < 4; ++j) c.sp8[j] = 8.f * log1pf(expf(-lam[j]));
}
struct LruRaw { u32x4 v[2][4]; };
__device__ __forceinline__ void lru_fetch(const Params& p, int tt, int hd, LruRaw& r) {
    const int tid = threadIdx.x;
    const bf16_t* ub = (const bf16_t*)(p.ws + OFF_REGB);
#pragma unroll
    for (int ps = 0; ps < 2; ++ps) {
        const int t = (tid >> 3) + ps * 64, c8 = tid & 7, tok = tt * 128 + t, ch0 = hd * 64 + c8 * 8;
        int tau, seq; const bool smp = tok >= NPTOK;
        if (!smp) { tau = tok & 2047; seq = tok >> 11; } else { tau = (tok - NPTOK) & 15; seq = (tok - NPTOK) >> 4; }
#pragma unroll
        for (int k = 0; k < 4; ++k) {
            const int st = tau + k - 3;
            if (st >= 0) r.v[ps][k] = *(const u32x4*)(ub + (size_t)(tok + k - 3) * 1024 + ch0);
            else if (smp) {
                const float* sp = p.in[4] + ((size_t)seq * 3 + (tau + k)) * 1024 + ch0;
                const f32x4 s0 = *(const f32x4*)sp, s1 = *(const f32x4*)(sp + 4);
                r.v[ps][k] = (u32x4){cvt_pk_bf16(s0[0], s0[1]), cvt_pk_bf16(s0[2], s0[3]), cvt_pk_bf16(s1[0], s1[1]), cvt_pk_bf16(s1[2], s1[3])};
            } else r.v[ps][k] = (u32x4){0u, 0u, 0u, 0u};
        }
    }
}
__device__ void lru_local_item(const Params& p, int tt, int hd, char* lds, const LruConsts& kc, const LruRaw& raw, LruRaw& nxt, int tt_next) {
    const int tid = threadIdx.x, lane = tid & 63, wid = __builtin_amdgcn_readfirstlane(tid >> 6), fr = lane & 15, fq = lane >> 4;
    char* sA = lds;
    float* xg = (float*)(lds + 16384);
    float* af = xg + 128 * 68;
    const bf16_t* ub = (const bf16_t*)(p.ws + OFF_REGB);
#pragma unroll
    for (int ps = 0; ps < 2; ++ps) {
        const int t = (tid >> 3) + ps * 64, c8 = tid & 7, ch0 = hd * 64 + c8 * 8;
        float xc[8];
        { const f32x4 b0 = *(const f32x4*)(p.in[18] + ch0), b1 = *(const f32x4*)(p.in[18] + ch0 + 4);
          xc[0] = b0[0]; xc[1] = b0[1]; xc[2] = b0[2]; xc[3] = b0[3]; xc[4] = b1[0]; xc[5] = b1[1]; xc[6] = b1[2]; xc[7] = b1[3]; }
#pragma unroll
        for (int k = 0; k < 4; ++k) {
            const u32x4 w = raw.v[ps][k];
            const f32x4 w0 = *(const f32x4*)(p.in[17] + k * 1024 + ch0), w1 = *(const f32x4*)(p.in[17] + k * 1024 + ch0 + 4);
            xc[0] += w0[0] * bflo(w[0]); xc[1] += w0[1] * bfhi(w[0]); xc[2] += w0[2] * bflo(w[1]); xc[3] += w0[3] * bfhi(w[1]);
            xc[4] += w1[0] * bflo(w[2]); xc[5] += w1[1] * bfhi(w[2]); xc[6] += w1[2] * bflo(w[3]); xc[7] += w1[3] * bfhi(w[3]);
        }
        u32x4 o; o[0] = cvt_pk_bf16(xc[0], xc[1]); o[1] = cvt_pk_bf16(xc[2], xc[3]); o[2] = cvt_pk_bf16(xc[4], xc[5]); o[3] = cvt_pk_bf16(xc[6], xc[7]);
        *(u32x4*)(sA + t * 128 + ((c8 ^ ((t >> 1) & 7)) * 16)) = o;
        *(f32x4*)(xg + t * 68 + c8 * 8) = (f32x4){xc[0], xc[1], xc[2], xc[3]};
        *(f32x4*)(xg + t * 68 + c8 * 8 + 4) = (f32x4){xc[4], xc[5], xc[6], xc[7]};
    }
    if (tt_next >= 0) lru_fetch(p, tt_next, hd, nxt);
    __syncthreads();
    {
        const int cb = wid & 3, th = wid >> 2;
        const int chl = cb * 16 + fq * 4;
        const bf16x8 br[2] = {kc.br[0], kc.br[1]}, bi[2] = {kc.bi[0], kc.bi[1]};
        const f32x4 ba = kc.ba, bx = kc.bx, sp8 = kc.sp8;
#pragma unroll
        for (int mb = 0; mb < 4; ++mb) {
            const int t = th * 64 + mb * 16 + fr;
            f32x4 ar = {0.f, 0.f, 0.f, 0.f}, ai = {0.f, 0.f, 0.f, 0.f};
#pragma unroll
            for (int ks = 0; ks < 2; ++ks) {
                const bf16x8 a = *(const bf16x8*)(sA + t * 128 + (((ks * 4 + fq) ^ ((t >> 1) & 7)) * 16));
                ar = __builtin_amdgcn_mfma_f32_16x16x32_bf16(br[ks], a, ar, 0, 0, 0);
                ai = __builtin_amdgcn_mfma_f32_16x16x32_bf16(bi[ks], a, ai, 0, 0, 0);
            }
            const f32x4 xc = *(const f32x4*)(xg + t * 68 + chl);
            f32x4 av, gv;
#pragma unroll
            for (int j = 0; j < 4; ++j) {
                const float r = sigm(ar[j] + ba[j]), ig = sigm(ai[j] + bx[j]);
                float la = -sp8[j] * r;
                const float a = __expf(la), x2 = 2.f * la;
                const float om = (x2 > -0.1f) ? -x2 * (1.f + x2 * (0.5f + x2 * (0.16666667f + x2 * 0.041666668f))) : 1.f - a * a;
                av[j] = a; gv[j] = __builtin_amdgcn_sqrtf(fmaxf(om, 0.f)) * ig * xc[j];
            }
            *(f32x4*)(af + t * 68 + chl) = av;
            *(f32x4*)(xg + t * 68 + chl) = gv;
        }
    }
    __syncthreads();
    {
        const int sc = tid >> 6, chl = tid & 63, ch = hd * 64 + chl;
        bf16_t* hl = (bf16_t*)(p.ws + OFF_REGC);
        bf16_t* pb = (bf16_t*)(p.ws + OFF_REGA);
        float h = 0.f, P = 1.f;
#pragma unroll
        for (int s = 0; s < 16; ++s) {
            const int t = sc * 16 + s;
            const float a = af[t * 68 + chl], g = xg[t * 68 + chl];
            h = a * h + g; P *= a;
            const size_t o = (size_t)(tt * 128 + t) * 1024 + ch;
            hl[o] = f2bf(h); pb[o] = f2bf(P);
        }
        const size_t n = (size_t)tt * 8 + sc;
        ((float*)(p.ws + OFF_PEND))[n * 1024 + ch] = P;
        ((float*)(p.ws + OFF_HEND))[n * 1024 + ch] = h;
    }
    __syncthreads();
}

__device__ void phase_m1(const Params& p, char* lds) {
    constexpr int N_SE = 32 * 5, N_LRU = (NTOK / 128) * 16;
    const int bx = blockIdx.x;
    if (bx < N_SE) {
        const int g = bx / 5, mt = bx % 5;
        f32x4 acc[4][4]; zero_acc(acc);
        gemm_acc<4, 2>(acc, (const bf16_t*)(p.ws + OFF_UAX) + (size_t)g * NSUBP * 384, 384,
                       (const bf16_t*)(p.ws + OFF_BTE) + (size_t)g * 128 * 256, 256, 256, mt * 256, 0, lds);
        float* se = (float*)(p.ws + OFF_SEND) + (size_t)g * NSUBP * 128;
        gemm_epi<4, 2>(acc, mt * 256, 0, [&](int r, int c, const f32x4& v) { if (r < NSUB) *(f32x4*)(se + (size_t)r * 128 + c) = v; });
    }
    int it = bx < N_SE ? bx + (256 - N_SE) : bx - N_SE;
    if (it < N_LRU) {
        const int hd = it & 15;
        LruConsts kc; lru_load_consts(p, hd, kc);
        LruRaw ra, rb;
        lru_fetch(p, it >> 4, hd, ra);
        for (;;) {
            int nx = it + 256;
            lru_local_item(p, it >> 4, hd, lds, kc, ra, rb, nx < N_LRU ? (nx >> 4) : -1);
            if (nx >= N_LRU) break;
            it = nx; nx = it + 256;
            lru_local_item(p, it >> 4, hd, lds, kc, rb, ra, nx < N_LRU ? (nx >> 4) : -1);
            if (nx >= N_LRU) break;
            it = nx;
        }
    }
}

__device__ void phase_m2(const Params& p) {
    const int tid = threadIdx.x, b = blockIdx.x;
    if (b < 128) {
        for (int pass = 0; pass < 2; ++pass) {
            const bool prompt = pass == 0;
            if (prompt && tid >= 128) continue;
            const int idx = prompt ? b * 128 + tid : b * 512 + tid;
            const int seq = idx >> 11, g = (idx >> 6) & 31, pi = idx & 63;
            float lr, li, cr, ci; s5_disc(p, g, pi, lr, li, cr, ci);
#pragma unroll
            for (int s = 0; s < 4; ++s) { const float nr = lr * lr - li * li, ni = 2.f * lr * li; lr = nr; li = ni; }
            const int n0 = prompt ? seq * 128 : 1024 + seq;
            float hr = 0.f, hi = 0.f;
            if (!prompt) { const f32x2 s0 = *(const f32x2*)(p.in[2] + (((size_t)seq * 32 + g) * 64 + pi) * 2); hr = s0[0]; hi = s0[1]; }
            const float* S = (const float*)(p.ws + OFF_SEND) + ((size_t)g * NSUBP + n0) * 128 + 2 * pi;
            bf16_t* H = (bf16_t*)(p.ws + OFF_UAX) + ((size_t)g * NSUBP + n0) * 384 + 256 + 2 * pi;
            if (prompt) {
                f32x2 sb[2][32];
#pragma unroll
                for (int j = 0; j < 32; ++j) sb[0][j] = *(const f32x2*)(S + (size_t)j * 128);
#pragma unroll
                for (int kb = 0; kb < 4; ++kb) {
                    if (kb + 1 < 4) {
#pragma unroll
                        for (int j = 0; j < 32; ++j) sb[(kb + 1) & 1][j] = *(const f32x2*)(S + (size_t)((kb + 1) * 32 + j) * 128);
                    }
                    __builtin_amdgcn_sched_barrier(0);
#pragma unroll
                    for (int j = 0; j < 32; ++j) {
                        *(unsigned*)(H + (size_t)(kb * 32 + j) * 384) = cvt_pk_bf16(hr, hi);
                        const float nr = lr * hr - li * hi + sb[kb & 1][j][0], ni = lr * hi + li * hr + sb[kb & 1][j][1]; hr = nr; hi = ni;
                    }
                    __builtin_amdgcn_sched_barrier(0);
                }
            } else {
                *(unsigned*)H = cvt_pk_bf16(hr, hi);
                const f32x2 sv = *(const f32x2*)S;
                const float nr = lr * hr - li * hi + sv[0], ni = lr * hi + li * hr + sv[1]; hr = nr; hi = ni;
            }
            float* o = p.out + (prompt ? O_S5P : O_S5S) + (((size_t)seq * 32 + g) * 64 + pi) * 2;
            *(f32x2*)o = (f32x2){hr, hi};
        }
    } else if (b < 192) {
        const int bb = b - 128;
        for (int pass = 0; pass < 2; ++pass) {
            const bool prompt = pass == 0;
            if (prompt && tid >= 128) continue;
            const int idx = prompt ? bb * 128 + tid : bb * 512 + tid;
            const int seq = idx >> 10, ch = idx & 1023;
            const int n0 = prompt ? seq * 128 : 1024 + seq;
            float h = prompt ? 0.f : p.in[3][(size_t)seq * 1024 + ch];
            const float* Pe = (const float*)(p.ws + OFF_PEND) + (size_t)n0 * 1024 + ch;
            const float* He = (const float*)(p.ws + OFF_HEND) + (size_t)n0 * 1024 + ch;
            float* Hi = (float*)(p.ws + OFF_HIN) + (size_t)n0 * 1024 + ch;
            if (prompt) {
                float pbuf[2][32], hbuf[2][32];
#pragma unroll
                for (int j = 0; j < 32; ++j) { pbuf[0][j] = Pe[(size_t)j * 1024]; hbuf[0][j] = He[(size_t)j * 1024]; }
#pragma unroll
                for (int kb = 0; kb < 4; ++kb) {
                    if (kb + 1 < 4) {
#pragma unroll
                        for (int j = 0; j < 32; ++j) { pbuf[(kb + 1) & 1][j] = Pe[(size_t)((kb + 1) * 32 + j) * 1024]; hbuf[(kb + 1) & 1][j] = He[(size_t)((kb + 1) * 32 + j) * 1024]; }
                    }
                    __builtin_amdgcn_sched_barrier(0);
#pragma unroll
                    for (int j = 0; j < 32; ++j) { Hi[(size_t)(kb * 32 + j) * 1024] = h; h = pbuf[kb & 1][j] * h + hbuf[kb & 1][j]; }
                    __builtin_amdgcn_sched_barrier(0);
                }
            } else {
                Hi[0] = h; h = Pe[0] * h + He[0];
            }
            p.out[(prompt ? O_LRUP : O_LRUS) + (size_t)seq * 1024 + ch] = h;
        }
    }
}

__device__ void phase_m3(const Params& p, char* lds) {
    constexpr int N_Y = 32 * 9, N_FIX = NTOK / 16;
    const int tid = threadIdx.x;
    const int bx = blockIdx.x;
    const int nstep = (bx >= 224) ? 2 : 1 + (N_FIX - bx + 223) / 224;
    for (int step = 0; step < nstep; ++step) {
        const int item = (step == 0) ? bx : (bx >= 224 ? 256 + (bx - 224) : N_Y + bx + (step - 1) * 224);
        if (item < N_Y) {
            const int g = item < 256 ? (item >> 3) : (item - 256), mt = item < 256 ? (item & 7) : 8;
            f32x4 acc[4][4]; zero_acc(acc);
            gemm_acc<2, 4>(acc, (const bf16_t*)(p.ws + OFF_UAX) + (size_t)g * NSUBP * 384, 384,
                           (const bf16_t*)(p.ws + OFF_BTY) + (size_t)g * 256 * 384, 384, 384, mt * 128, 0, lds);
            bf16_t* ya = (bf16_t*)(p.ws + OFF_REGB);
            gemm_epi<2, 4>(acc, mt * 128, 0, [&](int r, int c, const f32x4& v) {
                if (r < NSUB) {
                    const int t = c >> 4, co = c & 15;
                    u32x2 o; o[0] = cvt_pk_bf16(gelu_t(v[0]), gelu_t(v[1])); o[1] = cvt_pk_bf16(gelu_t(v[2]), gelu_t(v[3]));
                    *(u32x2*)(ya + ((size_t)r * 16 + t) * 512 + g * 16 + co) = o; } });
        } else {
            const int it = item - N_Y;
            u32x4 hl[4], pp[4], sz[4]; f32x4 h0[4], h1[4]; size_t off[4];
#pragma unroll
            for (int h = 0; h < 4; ++h) {
                const int v8 = it * 2048 + h * 512 + tid, tok = v8 >> 7, c0 = (v8 & 127) * 8;
                off[h] = (size_t)tok * 1024 + c0;
                hl[h] = __builtin_nontemporal_load((const u32x4*)((const bf16_t*)(p.ws + OFF_REGC) + off[h]));
                pp[h] = __builtin_nontemporal_load((const u32x4*)((const bf16_t*)(p.ws + OFF_REGA) + off[h]));
                sz[h] = __builtin_nontemporal_load((const u32x4*)((const bf16_t*)(p.ws + OFF_SZB) + off[h]));
                const float* hin = (const float*)(p.ws + OFF_HIN) + (size_t)(tok >> 4) * 1024 + c0;
                h0[h] = *(const f32x4*)hin; h1[h] = *(const f32x4*)(hin + 4);
            }
            __builtin_amdgcn_sched_barrier(0);
#pragma unroll
            for (int h = 0; h < 4; ++h) {
                u32x4 r;
                r[0] = cvt_pk_bf16((bflo(hl[h][0]) + bflo(pp[h][0]) * h0[h][0]) * bflo(sz[h][0]), (bfhi(hl[h][0]) + bfhi(pp[h][0]) * h0[h][1]) * bfhi(sz[h][0]));
                r[1] = cvt_pk_bf16((bflo(hl[h][1]) + bflo(pp[h][1]) * h0[h][2]) * bflo(sz[h][1]), (bfhi(hl[h][1]) + bfhi(pp[h][1]) * h0[h][3]) * bfhi(sz[h][1]));
                r[2] = cvt_pk_bf16((bflo(hl[h][2]) + bflo(pp[h][2]) * h1[h][0]) * bflo(sz[h][2]), (bfhi(hl[h][2]) + bfhi(pp[h][2]) * h1[h][1]) * bfhi(sz[h][2]));
                r[3] = cvt_pk_bf16((bflo(hl[h][3]) + bflo(pp[h][3]) * h1[h][2]) * bflo(sz[h][3]), (bfhi(hl[h][3]) + bfhi(pp[h][3]) * h1[h][3]) * bfhi(sz[h][3]));
                *(u32x4*)((bf16_t*)(p.ws + OFF_REGC) + off[h]) = r;
            }
        }
    }
}

__device__ __forceinline__ void g2_small_tile(const Params& p, char* lds, int mt, int nt) {
    const bf16_t* ya = (const bf16_t*)(p.ws + OFF_REGB);
    const bf16_t* sza = (const bf16_t*)(p.ws + OFF_SZA);
    bf16_t* va = (bf16_t*)(p.ws + OFF_SEND);
    const float* bg = p.in[16];
    {
        f32x4 acc[4][4]; zero_acc(acc);
        gemm_acc<2, 4>(acc, ya, 512, (const bf16_t*)(p.ws + OFF_WTGLU), 512, 512, mt * 128, nt * 256, lds);
        gemm_epi<2, 4>(acc, mt * 128, nt * 256, [&](int r, int c, const f32x4& v) {
            const u32x2 y = *(const u32x2*)(ya + (size_t)r * 512 + c), z = *(const u32x2*)(sza + (size_t)r * 512 + c);
            const f32x4 b = *(const f32x4*)(bg + c);
            u32x2 o;
            o[0] = cvt_pk_bf16(bflo(y[0]) * sigm(v[0] + b[0]) * bflo(z[0]), bfhi(y[0]) * sigm(v[1] + b[1]) * bfhi(z[0]));
            o[1] = cvt_pk_bf16(bflo(y[1]) * sigm(v[2] + b[2]) * bflo(z[1]), bfhi(y[1]) * sigm(v[3] + b[3]) * bfhi(z[1]));
            *(u32x2*)(va + (size_t)r * 512 + c) = o; });
    }
}

__device__ void phase_g2(const Params& p, char* lds) {
    const bf16_t* ya = (const bf16_t*)(p.ws + OFF_REGB);
    const bf16_t* sza = (const bf16_t*)(p.ws + OFF_SZA);
    bf16_t* va = (bf16_t*)(p.ws + OFF_SEND);
    const float* bg = p.in[16];
    auto f = [=](int r, int c, const f32x4& v0, const f32x4& v1) {
        const u32x4 y = *(const u32x4*)(ya + (size_t)r * 512 + c), z = *(const u32x4*)(sza + (size_t)r * 512 + c);
        const f32x4 b0 = *(const f32x4*)(bg + c), b1 = *(const f32x4*)(bg + c + 4);
        u32x4 o;
        o[0] = cvt_pk_bf16(bflo(y[0]) * sigm(v0[0] + b0[0]) * bflo(z[0]), bfhi(y[0]) * sigm(v0[1] + b0[1]) * bfhi(z[0]));
        o[1] = cvt_pk_bf16(bflo(y[1]) * sigm(v0[2] + b0[2]) * bflo(z[1]), bfhi(y[1]) * sigm(v0[3] + b0[3]) * bfhi(z[1]));
        o[2] = cvt_pk_bf16(bflo(y[2]) * sigm(v1[0] + b1[0]) * bflo(z[2]), bfhi(y[2]) * sigm(v1[1] + b1[1]) * bfhi(z[2]));
        o[3] = cvt_pk_bf16(bflo(y[3]) * sigm(v1[2] + b1[2]) * bflo(z[3]), bfhi(y[3]) * sigm(v1[3] + b1[3]) * bfhi(z[3]));
        *(u32x4*)(va + (size_t)r * 512 + c) = o; };
    Epi8<decltype(f)> e{f};
    run_gemm256(lds, ya, (const bf16_t*)(p.ws + OFF_WTGLU), NPTOK, 512, 512, e);
    { const int t = (int)blockIdx.x - 128; if (t >= 0 && t < 8) g2_small_tile(p, lds, 128 + (t >> 1), t & 1); }
}


struct EpiNorm {
    static constexpr bool PERM = false, AFTER_DRAIN = true;
    float* y; const float* x; const float* gain; float* part; unsigned* cnt; int panel0;
    __device__ __forceinline__ void fused(f32x4 (&acc)[2][2][4][2], const pg8::Unit& u, int wr, int wc, int fr, int fq, PG8_LAS unsigned char* lds, int wid, int lane) const {
        const int tid = wid * 64 + lane;
        const int row0 = u.pm * 256 + wr * 64 + fr, col0 = u.pn * 256 + wc * 32 + 4 * fq;
        PG8_LAS float* sl = (PG8_LAS float*)lds;
        float ss[2][4];
#pragma unroll
        for (int ai = 0; ai < 2; ++ai) {
            f32x4 xv[4][2][2];
#pragma unroll
            for (int m = 0; m < 4; ++m) {
                const float* xr = x + (size_t)(row0 + ai * 128 + m * 16) * 1024 + col0;
#pragma unroll
                for (int bj = 0; bj < 2; ++bj)
#pragma unroll
                    for (int n = 0; n < 2; ++n) xv[m][bj][n] = __builtin_nontemporal_load((const f32x4*)(xr + bj * 128 + n * 16));
            }
            __builtin_amdgcn_sched_barrier(0);
#pragma unroll
            for (int m = 0; m < 4; ++m) {
                float sacc = 0.f;
#pragma unroll
                for (int bj = 0; bj < 2; ++bj)
#pragma unroll
                    for (int n = 0; n < 2; ++n) {
                        const f32x4 v = acc[ai][bj][m][n] + xv[m][bj][n];
                        acc[ai][bj][m][n] = v;
                        sacc += v[0] * v[0] + v[1] * v[1] + v[2] * v[2] + v[3] * v[3];
                    }
                sacc += __shfl_xor(sacc, 16); sacc += __shfl_xor(sacc, 32);
                ss[ai][m] = sacc;
            }
            __builtin_amdgcn_sched_barrier(0);
        }
        if (fq == 0) {
#pragma unroll
            for (int ai = 0; ai < 2; ++ai)
#pragma unroll
                for (int m = 0; m < 4; ++m) sl[(ai * 128 + wr * 64 + m * 16 + fr) * 4 + wc] = ss[ai][m];
        }
        __syncthreads();
        float* slot = part + ((size_t)(panel0 + u.pm) * 4) * 256;
        if (tid < 256) {
            const float tot = sl[tid * 4 + 0] + sl[tid * 4 + 1] + sl[tid * 4 + 2] + sl[tid * 4 + 3];
            __hip_atomic_store(slot + (size_t)u.pn * 256 + tid, tot, __ATOMIC_RELAXED, __HIP_MEMORY_SCOPE_AGENT);
        }
        asm volatile("s_waitcnt vmcnt(0)" ::: "memory");
        __syncthreads();
        if (tid == 0) {
            unsigned* c = cnt + panel0 + u.pm;
            __hip_atomic_fetch_add(c, 1u, __ATOMIC_RELAXED, __HIP_MEMORY_SCOPE_AGENT);
            unsigned sp = 0;
            while (__hip_atomic_load(c, __ATOMIC_RELAXED, __HIP_MEMORY_SCOPE_AGENT) < 4u) { __builtin_amdgcn_s_sleep(1); if (++sp > (1u << 22)) break; }
        }
        __syncthreads();
        if (tid < 256) {
            float t = 0.f;
#pragma unroll
            for (int q = 0; q < 4; ++q) t += __hip_atomic_load(slot + (size_t)q * 256 + tid, __ATOMIC_RELAXED, __HIP_MEMORY_SCOPE_AGENT);
            sl[1024 + tid] = rsqrtf(t * (1.f / 1024.f) + 1e-6f);
        }
        __syncthreads();
#pragma unroll
        for (int ai = 0; ai < 2; ++ai)
#pragma unroll
            for (int m = 0; m < 4; ++m) {
                const int rl = ai * 128 + wr * 64 + m * 16 + fr;
                const float rs = sl[1024 + rl];
                float* yr = y + (size_t)(u.pm * 256 + rl) * 1024 + col0;
#pragma unroll
                for (int bj = 0; bj < 2; ++bj)
#pragma unroll
                    for (int n = 0; n < 2; ++n) {
                        const f32x4 g = *(const f32x4*)(gain + col0 + bj * 128 + n * 16);
                        __builtin_nontemporal_store(acc[ai][bj][m][n] * rs * g, (f32x4*)(yr + bj * 128 + n * 16));
                    }
                __builtin_amdgcn_sched_barrier(0);
            }
        __syncthreads();
    }
};
__device__ void phase_g3(const Params& p, char* lds) {
    const bf16_t* va = (const bf16_t*)(p.ws + OFF_SEND);
    const bf16_t* vb = (const bf16_t*)(p.ws + OFF_REGC);
    const bf16_t* sg = (const bf16_t*)(p.out + O_Y);
    bf16_t* m = (bf16_t*)(p.ws + OFF_REGA);
    unsigned* cntS = (unsigned*)(p.ws + OFF_BAR) + 3584 + 200;
    const int bx = blockIdx.x;
    const int nstep = (bx >= 248) ? 1 : (bx >= 16 && bx < 24) ? 3 : 2;
    for (int step = (bx < 16 ? -1 : 0); step < nstep; ++step) {
        const bool smp_tile = step < 0;
        const int tile = smp_tile ? 512 + bx : (step == 2 ? 488 + bx : bx + 256 * step);
        const int mt = tile >> 2, nt = tile & 3, row0 = mt * 128, col0 = nt * 256;
        f32x4 acc[4][4]; zero_acc(acc);
        gemm_acc<2, 4>(acc, va, 512, (const bf16_t*)(p.ws + OFF_WTPA), 512, 512, row0, col0, lds);
        f32x4 acc2[4][4]; zero_acc(acc2);
        gemm_acc<2, 4>(acc2, vb, 1024, (const bf16_t*)(p.ws + OFF_WTPB), 1024, 1024, row0, col0, lds);
        {
            const int lane = threadIdx.x & 63, wid = threadIdx.x >> 6, wr = wid / 4, wc = wid % 4, fr = lane & 15, fq = lane >> 4;
#pragma unroll
            for (int mi = 0; mi < 4; ++mi) {
                __builtin_amdgcn_sched_barrier(0);
#pragma unroll
                for (int ni = 0; ni < 4; ++ni) {
                    const int r = row0 + wr * 64 + mi * 16 + fr, c = col0 + wc * 64 + ni * 16 + fq * 4;
                    const u32x2 ga = *(const u32x2*)(sg + (size_t)r * 2048 + c), gb = *(const u32x2*)(sg + (size_t)r * 2048 + 1024 + c);
                    const f32x4 a = acc[mi][ni], b = acc2[mi][ni];
                    u32x2 o;
                    o[0] = cvt_pk_bf16(bflo(ga[0]) * a[0] + bflo(gb[0]) * b[0], bfhi(ga[0]) * a[1] + bfhi(gb[0]) * b[1]);
                    o[1] = cvt_pk_bf16(bflo(ga[1]) * a[2] + bflo(gb[1]) * b[2], bfhi(ga[1]) * a[3] + bfhi(gb[1]) * b[3]);
                    if (smp_tile) {
                        __hip_atomic_store((unsigned*)(m + (size_t)r * 1024 + c), o[0], __ATOMIC_RELAXED, __HIP_MEMORY_SCOPE_AGENT);
                        __hip_atomic_store((unsigned*)(m + (size_t)r * 1024 + c) + 1, o[1], __ATOMIC_RELAXED, __HIP_MEMORY_SCOPE_AGENT);
                    } else *(u32x2*)(m + (size_t)r * 1024 + c) = o;
                }
            }
        }
        if (smp_tile) {
            asm volatile("s_waitcnt vmcnt(0)" ::: "memory");
            __syncthreads();
            if (threadIdx.x == 0) __hip_atomic_fetch_add(cntS, 1u, __ATOMIC_RELAXED, __HIP_MEMORY_SCOPE_AGENT);
        }
    }
    if (bx >= 248) {
        if (threadIdx.x == 0) { unsigned sp = 0; while (__hip_atomic_load(cntS, __ATOMIC_RELAXED, __HIP_MEMORY_SCOPE_AGENT) < 16u) { __builtin_amdgcn_s_sleep(2); if (++sp > (1u << 22)) break; } }
        __syncthreads();
        float* part = (float*)(p.ws + OFF_PEND);
        unsigned* cnt = (unsigned*)(p.ws + OFF_BAR) + 3584;
        EpiNorm e{p.out + O_Y + (size_t)NPTOK * 1024, p.in[1], p.in[27], part, cnt, 64};
        run_gemm256(lds, (const bf16_t*)(p.ws + OFF_REGA) + (size_t)NPTOK * 1024, (const bf16_t*)(p.ws + OFF_WTOUT), NTOK - NPTOK, 1024, 1024, e, 248);
    }
}
__device__ void phase_g4(const Params& p, char* lds) {
    float* part = (float*)(p.ws + OFF_PEND);
    unsigned* cnt = (unsigned*)(p.ws + OFF_BAR) + 3584;
    {
        EpiNorm e{p.out + O_Y, p.in[0], p.in[27], part, cnt, 0};
        run_gemm256(lds, (const bf16_t*)(p.ws + OFF_REGA), (const bf16_t*)(p.ws + OFF_WTOUT), NPTOK, 1024, 1024, e);
    }
}

__device__ void phase_n5(const Params& p) {
    const int lane = threadIdx.x & 63, wid = __builtin_amdgcn_readfirstlane(threadIdx.x >> 6);
    for (int item = blockIdx.x; item < NTOK / 16; item += gridDim.x) {
        const int tok0 = item * 16 + wid * 2;
        f32x4 v[2][4];
#pragma unroll
        for (int rr = 0; rr < 2; ++rr) {
            const float* y = p.out + O_Y + (size_t)(tok0 + rr) * 1024 + lane * 4;
#pragma unroll
            for (int i = 0; i < 4; ++i) v[rr][i] = *(const f32x4*)(y + i * 256);
        }
        f32x4 g[4];
#pragma unroll
        for (int i = 0; i < 4; ++i) g[i] = *(const f32x4*)(p.in[27] + lane * 4 + i * 256);
#pragma unroll
        for (int rr = 0; rr < 2; ++rr) {
            float ss = 0.f;
#pragma unroll
            for (int i = 0; i < 4; ++i) ss += v[rr][i][0] * v[rr][i][0] + v[rr][i][1] * v[rr][i][1] + v[rr][i][2] * v[rr][i][2] + v[rr][i][3] * v[rr][i][3];
#pragma unroll
            for (int o = 32; o; o >>= 1) ss += __shfl_xor(ss, o);
            const float rs = rsqrtf(ss * (1.f / 1024.f) + 1e-6f);
            float* y = p.out + O_Y + (size_t)(tok0 + rr) * 1024 + lane * 4;
#pragma unroll
            for (int i = 0; i < 4; ++i) *(f32x4*)(y + i * 256) = v[rr][i] * rs * g[i];
        }
    }
}

__device__ __forceinline__ void run_phase(const Params& p, int ph, char* lds) {
    switch (ph) {
        case 0: phase_prep(p, lds); break;
        case 1: phase_gemm1(p, lds); break;
        case 2: phase_m1(p, lds); break;
        case 3: phase_m2(p); break;
        case 4: phase_m3(p, lds); break;
        case 5: phase_g2(p, lds); break;
        case 6: phase_g3(p, lds); break;
        case 7: phase_g4(p, lds); break;
        default: phase_n5(p); break;
    }
}

typedef const __attribute__((address_space(4))) Params* KernargP;
__device__ __forceinline__ Params load_params() {
#if defined(__HIP_DEVICE_COMPILE__)
    KernargP kp = (KernargP)__builtin_amdgcn_kernarg_segment_ptr();
    asm volatile("" : "+s"(kp));
    return *kp;
#else
    return Params{};
#endif
}

#if MULTI
template <int PH>
__global__ void __launch_bounds__(NT) phase_kernel(Params p) {
    __shared__ __attribute__((aligned(16))) char lds[LDS_BYTES];
    run_phase(p, PH, lds);
}
#else
__global__ void __launch_bounds__(NT) hybrid_s5_rglru_megakernel(Params p, int use_cg) {
    __shared__ __attribute__((aligned(16))) char lds[LDS_BYTES];
    __shared__ uint4 xbw;
    if (threadIdx.x == 0) xbw = make_uint4(0u, 0u, 0u, 0u);
    __syncthreads();
    XcdBarrier xb = xcd_barrier_post((unsigned*)(p.ws + OFF_BAR), (volatile LAS unsigned*)&xbw);
    if (use_cg) cg::this_grid().sync();
    { const Params q = load_params(); phase_prep(q, lds); }  xcd_barrier(xb);
    { const Params q = load_params(); phase_gemm1(q, lds); } xcd_barrier(xb);
    { const Params q = load_params(); phase_m1(q, lds); }    xcd_barrier(xb);
    { const Params q = load_params(); phase_m2(q); }         xcd_barrier(xb);
    { const Params q = load_params(); phase_m3(q, lds); }    xcd_barrier(xb);
    { const Params q = load_params(); phase_g2(q, lds); }    xcd_barrier(xb);
    { const Params q = load_params(); phase_g3(q, lds); }    xcd_barrier(xb);
    { const Params q = load_params(); phase_g4(q, lds); }
}
#endif

extern "C" void kernel_launch(void* const* d_in, const int* in_sizes, int n_in, void* d_out, int out_size, void* d_ws, size_t ws_size,
                              hipStream_t stream) {
    Params p{};
    for (int i = 0; i < 28; ++i) p.in[i] = (const float*)d_in[i];
    p.out = (float*)d_out; p.ws = (char*)d_ws;
#if MULTI
    phase_kernel<0><<<256, NT, 0, stream>>>(p);
    phase_kernel<1><<<256, NT, 0, stream>>>(p);
    phase_kernel<2><<<256, NT, 0, stream>>>(p);
    phase_kernel<3><<<256, NT, 0, stream>>>(p);
    phase_kernel<4><<<256, NT, 0, stream>>>(p);
    phase_kernel<5><<<256, NT, 0, stream>>>(p);
    phase_kernel<6><<<256, NT, 0, stream>>>(p);
    phase_kernel<7><<<256, NT, 0, stream>>>(p);
#else
    static int grid_blocks = 0;
    if (!grid_blocks) {
        int dev = 0, cus = 0, per_cu = 0;
        hipGetDevice(&dev);
        hipDeviceGetAttribute(&cus, hipDeviceAttributeMultiprocessorCount, dev);
        hipOccupancyMaxActiveBlocksPerMultiprocessor(&per_cu, hybrid_s5_rglru_megakernel, NT, 0);
        if (per_cu > 1) per_cu = 1;
        grid_blocks = cus * (per_cu > 0 ? per_cu : 1);
    }
    hipMemsetAsync(d_ws, 0, 16384, stream);
    int use_cg = 0;
    void* args[] = {&p, &use_cg};
    hipError_t e = hipLaunchCooperativeKernel((void*)hybrid_s5_rglru_megakernel, dim3(grid_blocks), dim3(NT), args, 0, stream);
    if (e != hipSuccess) fprintf(stderr, "cooperative launch failed: %s (grid %d)\n", hipGetErrorString(e), grid_blocks);
#endif
}
```

```cpp
#include <hip/hip_runtime.h>
#include <hip/hip_cooperative_groups.h>
#include <stdint.h>
#include <cstdio>
namespace cg = cooperative_groups;

#ifndef MULTI
#define MULTI 0
#endif

typedef unsigned short bf16_t;
typedef short bf16x8 __attribute__((ext_vector_type(8)));
typedef float f32x4 __attribute__((ext_vector_type(4)));
typedef float f32x2 __attribute__((ext_vector_type(2)));
typedef unsigned u32x4 __attribute__((ext_vector_type(4)));
typedef unsigned u32x2 __attribute__((ext_vector_type(2)));

#define NT 512
constexpr int NTOK = 16896, NPTOK = 16384;
constexpr int NSUB = 1056, NSUBP = 1280;
constexpr int LDS_BYTES = 147456;

struct Params { const float* in[28]; float* out; char* ws; };

constexpr size_t OFF_BAR   = 0;
constexpr size_t OFF_WTIN  = 16384;
constexpr size_t OFF_WTGLU = OFF_WTIN  + 5120ull * 1024 * 2;
constexpr size_t OFF_WTPA  = OFF_WTGLU + 512ull * 512 * 2;
constexpr size_t OFF_WTPB  = OFF_WTPA  + 1024ull * 512 * 2;
constexpr size_t OFF_WTOUT = OFF_WTPB  + 1024ull * 1024 * 2;
constexpr size_t OFF_WTG   = OFF_WTOUT + 1024ull * 1024 * 2;
constexpr size_t OFF_BTE   = OFF_WTG   + 16ull * 128 * 64 * 2;
constexpr size_t OFF_BTY   = OFF_BTE   + 32ull * 128 * 256 * 2;
constexpr size_t OFF_UAX   = OFF_BTY   + 32ull * 256 * 384 * 2;
constexpr size_t OFF_SZA   = OFF_UAX   + 32ull * NSUBP * 384 * 2;
constexpr size_t OFF_REGA  = OFF_SZA   + (size_t)NTOK * 512 * 2;
constexpr size_t OFF_REGB  = OFF_REGA  + (size_t)NTOK * 1024 * 2;
constexpr size_t OFF_REGC  = OFF_REGB  + (size_t)NTOK * 1024 * 2;
constexpr size_t OFF_SZB   = OFF_REGC  + (size_t)NTOK * 1024 * 2;
constexpr size_t OFF_SEND  = OFF_SZB   + (size_t)NTOK * 1024 * 2;
constexpr size_t OFF_PEND  = OFF_SEND  + 32ull * NSUBP * 128 * 4;
constexpr size_t OFF_HEND  = OFF_PEND  + (size_t)NSUB * 1024 * 4;
constexpr size_t OFF_HIN   = OFF_HEND  + (size_t)NSUB * 1024 * 4;
constexpr size_t WS_TOTAL  = OFF_HIN   + (size_t)NSUB * 1024 * 4;

constexpr size_t O_Y = 0;
constexpr size_t O_S5P = 17301504, O_LRUP = 17334272, O_CONVP = 17342464;
constexpr size_t O_S5S = 17367040, O_LRUS = 17498112, O_CONVS = 17530880;

typedef __bf16 bf16x2_t __attribute__((ext_vector_type(2)));
__device__ __forceinline__ unsigned cvt_pk_bf16(float lo, float hi) {
    const f32x2 v = {lo, hi};
    const bf16x2_t b = __builtin_convertvector(v, bf16x2_t);
    return __builtin_bit_cast(unsigned, b);
}
__device__ __forceinline__ bf16_t f2bf(float f) { return (bf16_t)(cvt_pk_bf16(f, 0.f) & 0xffffu); }
__device__ __forceinline__ float bf2f(unsigned b) { return __uint_as_float(b << 16); }
__device__ __forceinline__ float bflo(unsigned w) { return __uint_as_float(w << 16); }
__device__ __forceinline__ float bfhi(unsigned w) { return __uint_as_float(w & 0xffff0000u); }
__device__ __forceinline__ float sigm(float x) { return __builtin_amdgcn_rcpf(1.f + __expf(-x)); }
__device__ __forceinline__ float silu(float x) { return x * sigm(x); }
__device__ __forceinline__ float gelu_t(float x) { return x * sigm(1.5957691216f * (x + 0.044715f * x * x * x)); }
__device__ __forceinline__ const float* xrow(const Params& p, int tok) {
    return tok < NPTOK ? p.in[0] + (size_t)tok * 1024 : p.in[1] + (size_t)(tok - NPTOK) * 1024;
}
__device__ __forceinline__ void glds16_asm(const void* gsrc, unsigned lds_dst) {
    unsigned keep;
    asm volatile("s_mov_b32 %0, m0\n\ts_mov_b32 m0, %2\n\ts_nop 0\n\tglobal_load_lds_dwordx4 %1, off\n\ts_mov_b32 m0, %0"
                 : "=&s"(keep) : "v"(gsrc), "s"(lds_dst) : "memory");
}
__device__ __forceinline__ unsigned lds_addr(const void* p) { return (unsigned)(size_t)(const __attribute__((address_space(3))) char*)p; }

#define XB_TMO      128
#define XB_XCNT(j)  (256  + 64 * (j))
#define XB_XSUB(j)  (1280 + 64 * (j))
#define XB_XGEN(j)  (2304 + 64 * (j))
#define XB_TOP      3328
#define XB_TOPGEN   3392
#define XCD_BAR_WORDS 3456
#define XB_SPIN_CAP (1u << 20)
#define LAS __attribute__((address_space(3)))
__device__ __forceinline__ unsigned xb_ld(unsigned* p)              { return __hip_atomic_load(p, __ATOMIC_RELAXED, __HIP_MEMORY_SCOPE_AGENT); }
__device__ __forceinline__ unsigned xb_add(unsigned* p, unsigned v) { return __hip_atomic_fetch_add(p, v, __ATOMIC_RELAXED, __HIP_MEMORY_SCOPE_AGENT); }
__device__ __forceinline__ unsigned xb_xcc_id() { return (unsigned)__builtin_amdgcn_s_getreg((3 << 11) | 20) & 0xFu; }
#define XB_SPIN(cond, bar) do { unsigned _sp = 0; while (cond) { __builtin_amdgcn_s_sleep(1); \
    if ((++_sp & 255u) == 0u) { if (xb_ld(&(bar)[XB_TMO])) break; if (_sp > XB_SPIN_CAP) { atomicAdd(&(bar)[XB_TMO], 1u); break; } } } } while (0)
struct XcdBarrier { unsigned* bar; unsigned x; volatile LAS unsigned* st; };
__device__ __forceinline__ XcdBarrier xcd_barrier_post(unsigned* bar, volatile LAS unsigned* st) {
    XcdBarrier b; b.bar = bar; b.x = xb_xcc_id(); b.st = st;
    if (threadIdx.x == 0) (void)xb_add(&bar[XB_XCNT(b.x)], 1u);
    return b;
}
__device__ __forceinline__ void xcd_barrier_complete(unsigned* bar, unsigned x, unsigned& nloc, unsigned& nx) {
    const unsigned G = gridDim.x * gridDim.y * gridDim.z;
    unsigned sum, cnt, mine, sp = 0u;
    for (;;) {
        sum = 0u; cnt = 0u; mine = 0u;
#pragma unroll
        for (unsigned j = 0; j < 16; ++j) { const unsigned c = xb_ld(&bar[XB_XCNT(j)]); sum += c; cnt += (c > 0u) ? 1u : 0u; mine = (j == x) ? c : mine; }
        if (sum == G) break;
        __builtin_amdgcn_s_sleep(1);
        if ((++sp & 255u) == 0u) { if (xb_ld(&bar[XB_TMO])) break; if (sp > XB_SPIN_CAP) { atomicAdd(&bar[XB_TMO], 1u); break; } }
    }
    nloc = mine > 0u ? mine : 1u; nx = cnt > 0u ? cnt : 1u;
}
__device__ __forceinline__ void xcd_barrier(const XcdBarrier& b) {
    asm volatile("s_waitcnt vmcnt(0)" ::: "memory");
    __syncthreads();
    if (threadIdx.x == 0) {
        unsigned* bar = b.bar;
        __builtin_amdgcn_s_waitcnt(0);
        unsigned nloc = b.st[0], nx = b.st[1];
        if (nloc == 0u) { xcd_barrier_complete(bar, b.x, nloc, nx); b.st[0] = nloc; b.st[1] = nx; }
        const unsigned old = xb_add(&bar[XB_XSUB(b.x)], 1u);
        const unsigned gen = old / nloc;
        if (old + 1u == (gen + 1u) * nloc) {
            __builtin_amdgcn_fence(__ATOMIC_RELEASE, "agent");
            asm volatile("s_waitcnt vmcnt(0)" ::: "memory");
            const unsigned og = xb_add(&bar[XB_TOP], 1u);
            const unsigned tg = og / nx;
            if (og + 1u == (tg + 1u) * nx) xb_add(&bar[XB_TOPGEN], 1u);
            else XB_SPIN(xb_ld(&bar[XB_TOPGEN]) == tg, bar);
            __builtin_amdgcn_fence(__ATOMIC_ACQUIRE, "agent");
            xb_add(&bar[XB_XGEN(b.x)], 1u);
            asm volatile("s_waitcnt vmcnt(0)" ::: "memory");
        } else {
            XB_SPIN(xb_ld(&bar[XB_XGEN(b.x)]) == gen, bar);
            __builtin_amdgcn_fence(__ATOMIC_ACQUIRE, "agent");
            asm volatile("s_waitcnt vmcnt(0)" ::: "memory");
        }
    }
    __syncthreads();
}

template <int WR, int WC>
__device__ __forceinline__ void gemm_acc(f32x4 (&acc)[4][4], const bf16_t* __restrict__ A, int lda, const bf16_t* __restrict__ Bt, int ldb,
                                         int K, int row0, int col0, char* lds) {
    constexpr int BM = 64 * WR, BN = 64 * WC, STAGE = (BM + BN) * 128;
    static_assert(BM / 64 + BN / 64 == 6, "vmcnt(6) below assumes 6 LDS-DMA loads per thread per K-tile");
    const int tid = threadIdx.x, lane = tid & 63, wid = __builtin_amdgcn_readfirstlane(tid >> 6);
    const int wr = wid / WC, wc = wid % WC, fr = lane & 15, fq = lane >> 4;
    const int nk = K >> 6;
    const int sr = tid >> 3, sp = tid & 7;
    const int sc = sp ^ ((sr >> 1) & 7);
    const bf16_t* ga = A + (size_t)(row0 + sr) * lda + sc * 8;
    const bf16_t* gb = Bt + (size_t)(col0 + sr) * ldb + sc * 8;
    const unsigned ldsw = lds_addr(lds) + (unsigned)wid * 1024u;
    auto stage = [&](int kt, int buf) {
        const unsigned base = ldsw + (unsigned)(buf * STAGE);
#pragma unroll
        for (int i = 0; i < BM / 64; ++i) glds16_asm(ga + (size_t)i * 64 * lda + kt * 64, base + i * 8192);
#pragma unroll
        for (int i = 0; i < BN / 64; ++i) glds16_asm(gb + (size_t)i * 64 * ldb + kt * 64, base + BM * 128 + i * 8192);
    };
    stage(0, 0);
    if (nk > 1) stage(1, 1);
    const int swz = fr >> 1;
    int buf = 0;
#pragma unroll 1
    for (int kt = 0; kt < nk; ++kt) {
        if (kt + 1 < nk) asm volatile("s_waitcnt vmcnt(6)" ::: "memory");
        else             asm volatile("s_waitcnt vmcnt(0)" ::: "memory");
        __builtin_amdgcn_s_barrier();
        asm volatile("" ::: "memory");
        if (kt + 2 < nk) { int b2 = buf + 2; if (b2 >= 3) b2 -= 3; stage(kt + 2, b2); }
        const char* sa = lds + buf * STAGE;
        const char* sb = sa + BM * 128;
#pragma unroll
        for (int ks = 0; ks < 2; ++ks) {
            bf16x8 af[4], bfr[4];
            const int pos = ((ks * 4 + fq) ^ swz) * 16;
#pragma unroll
            for (int mi = 0; mi < 4; ++mi) af[mi] = *(const bf16x8*)(sa + (wr * 64 + mi * 16 + fr) * 128 + pos);
#pragma unroll
            for (int ni = 0; ni < 4; ++ni) bfr[ni] = *(const bf16x8*)(sb + (wc * 64 + ni * 16 + fr) * 128 + pos);
            __builtin_amdgcn_s_setprio(1);
#pragma unroll
            for (int mi = 0; mi < 4; ++mi)
#pragma unroll
                for (int ni = 0; ni < 4; ++ni)
                    acc[mi][ni] = __builtin_amdgcn_mfma_f32_16x16x32_bf16(bfr[ni], af[mi], acc[mi][ni], 0, 0, 0);
            __builtin_amdgcn_s_setprio(0);
        }
        buf = (buf == 2) ? 0 : buf + 1;
    }
    __syncthreads();
}
template <int WR, int WC, class F>
__device__ __forceinline__ void gemm_epi(const f32x4 (&acc)[4][4], int row0, int col0, F f) {
    const int lane = threadIdx.x & 63, wid = __builtin_amdgcn_readfirstlane(threadIdx.x >> 6);
    const int wr = wid / WC, wc = wid % WC, fr = lane & 15, fq = lane >> 4;
#pragma unroll
    for (int mi = 0; mi < 4; ++mi) {
#pragma unroll
        for (int ni = 0; ni < 4; ++ni)
            f(row0 + wr * 64 + mi * 16 + fr, col0 + wc * 64 + ni * 16 + fq * 4, acc[mi][ni]);
        __builtin_amdgcn_sched_barrier(0);
    }
}
__device__ __forceinline__ void zero_acc(f32x4 (&acc)[4][4]) {
#pragma unroll
    for (int i = 0; i < 4; ++i)
#pragma unroll
        for (int j = 0; j < 4; ++j) acc[i][j] = (f32x4){0.f, 0.f, 0.f, 0.f};
}


struct TileOrder {
    int nM, nN, nt, xcd, li, per, lo, hi;
    __device__ __forceinline__ void init(int nM_, int nN_) {
        nM = nM_; nN = nN_; nt = nM * nN; xcd = blockIdx.x & 7; li = blockIdx.x >> 3; per = gridDim.x >> 3;
        const int q = nt / 8, r = nt % 8;
        lo = xcd < r ? xcd * (q + 1) : r * (q + 1) + (xcd - r) * q; hi = lo + (xcd < r ? q + 1 : q);
    }
    __device__ __forceinline__ bool get(int i, int& pm, int& pn) const {
        const int w = lo + i * per + li; if (w >= hi) return false;
        const int nig = 8 * nN, gid = w / nig, fm = gid * 8, gsz = (nM - fm) < 8 ? (nM - fm) : 8;
        pm = fm + (w % nig) % gsz; pn = (w % nig) / gsz; return true;
    }
};

__device__ __forceinline__ void s5_disc(const Params& p, int g, int pi, float& lbr, float& lbi, float& cr, float& ci) {
    const float dt = expf(p.in[9][g]);
    const float lr = p.in[7][g * 64 + pi], li = p.in[8][g * 64 + pi];
    const float mag = expf(lr * dt), ang = li * dt;
    float s, c; sincosf(ang, &s, &c);
    lbr = mag * c; lbi = mag * s;
    const float den = lr * lr + li * li, nr = lbr - 1.f;
    cr = (nr * lr + lbi * li) / den;
    ci = (lbi * lr - nr * li) / den;
}

__device__ void s5_tables(const Params& p, int g, int part, char* lds) {
    float* Cre = (float*)lds;
    float* Cim = Cre + 1024;
    float* Gre = Cim + 1024;
    float* Gim = Gre + 1024;
    const int tid = threadIdx.x;
    bf16_t* BtE = (bf16_t*)(p.ws + OFF_BTE) + (size_t)g * 128 * 256;
    bf16_t* BtY = (bf16_t*)(p.ws + OFF_BTY) + (size_t)g * 256 * 384;
    float lr_[2], li_[2], gr[2], gi[2];
#pragma unroll
    for (int h = 0; h < 2; ++h) {
        const int q = tid + 512 * h, pi = q >> 4, ci = q & 15;
        float cr, cim; s5_disc(p, g, pi, lr_[h], li_[h], cr, cim);
        const float br = p.in[10][(g * 64 + pi) * 16 + ci], bi = p.in[11][(g * 64 + pi) * 16 + ci];
        gr[h] = cr * br - cim * bi; gi[h] = cr * bi + cim * br;
        Cre[q] = p.in[12][g * 1024 + q]; Cim[q] = p.in[13][g * 1024 + q];
        float er = gr[h], ei = gi[h];
        for (int j = 15; j >= 0; --j) {
            if ((j >> 2) == part) {
                BtE[(2 * pi) * 256 + j * 16 + ci] = f2bf(er);
                BtE[(2 * pi + 1) * 256 + j * 16 + ci] = f2bf(ei);
            }
            const float nr = er * lr_[h] - ei * li_[h], ni = er * li_[h] + ei * lr_[h]; er = nr; ei = ni;
        }
    }
#pragma unroll
    for (int h = 0; h < 2; ++h) {
        const int q = tid + 512 * h, co = q >> 6, pi = q & 63;
        float lr, li, cr, cim; s5_disc(p, g, pi, lr, li, cr, cim);
        const float c_r = p.in[12][(g * 16 + co) * 64 + pi], c_i = p.in[13][(g * 16 + co) * 64 + pi];
        float qr = c_r * lr - c_i * li, qi = c_r * li + c_i * lr;
        for (int t = 0; t < 16; ++t) {
            if ((t >> 2) == part) *(unsigned*)(BtY + (size_t)(t * 16 + co) * 384 + 256 + 2 * pi) = cvt_pk_bf16(qr, -qi);
            const float nr = qr * lr - qi * li, ni = qr * li + qi * lr; qr = nr; qi = ni;
        }
    }
    for (int a = 0; a < 4 * part; ++a) {
#pragma unroll
        for (int h = 0; h < 2; ++h) { const float nr = gr[h] * lr_[h] - gi[h] * li_[h], ni = gr[h] * li_[h] + gi[h] * lr_[h]; gr[h] = nr; gi[h] = ni; }
    }
    for (int k = 4 * part; k < 4 * part + 4; ++k) {
        __syncthreads();
#pragma unroll
        for (int h = 0; h < 2; ++h) { const int q = tid + 512 * h; Gre[q] = gr[h]; Gim[q] = gi[h]; }
        __syncthreads();
        if (tid < 256) {
            const int co = tid >> 4, ci = tid & 15;
            float s = 0.f;
#pragma unroll 8
            for (int pi = 0; pi < 64; ++pi) s += Cre[co * 64 + pi] * Gre[pi * 16 + ci] - Cim[co * 64 + pi] * Gim[pi * 16 + ci];
            if (k == 0 && co == ci) s += p.in[14][g * 16 + co];
            const bf16_t v = f2bf(s);
            for (int t = k; t < 16; ++t) BtY[(size_t)(t * 16 + co) * 384 + (t - k) * 16 + ci] = v;
        } else if (k >= 1) {
            const int co = (tid - 256) >> 4, ci = tid & 15;
            for (int t = 0; t + k < 16; ++t) BtY[(size_t)(t * 16 + co) * 384 + (t + k) * 16 + ci] = 0;
        }
#pragma unroll
        for (int h = 0; h < 2; ++h) { const float nr = gr[h] * lr_[h] - gi[h] * li_[h], ni = gr[h] * li_[h] + gi[h] * lr_[h]; gr[h] = nr; gi[h] = ni; }
    }
    __syncthreads();
}

__device__ void transpose_tile(const float* __restrict__ src, int ldn, bf16_t* __restrict__ dst, int ldk, int k0, int n0, char* lds) {
    float* tile = (float*)lds;
    const int tid = threadIdx.x;
#pragma unroll
    for (int ps = 0; ps < 2; ++ps) {
        const int k = (tid >> 4) + ps * 32, n4 = (tid & 15) * 4;
        const f32x4 v = *(const f32x4*)(src + (size_t)(k0 + k) * ldn + n0 + n4);
        tile[k * 65 + n4 + 0] = v[0]; tile[k * 65 + n4 + 1] = v[1]; tile[k * 65 + n4 + 2] = v[2]; tile[k * 65 + n4 + 3] = v[3];
    }
    __syncthreads();
    {
        const int n = tid >> 3, kc = (tid & 7) * 8;
        u32x4 o;
        o[0] = cvt_pk_bf16(tile[(kc + 0) * 65 + n], tile[(kc + 1) * 65 + n]);
        o[1] = cvt_pk_bf16(tile[(kc + 2) * 65 + n], tile[(kc + 3) * 65 + n]);
        o[2] = cvt_pk_bf16(tile[(kc + 4) * 65 + n], tile[(kc + 5) * 65 + n]);
        o[3] = cvt_pk_bf16(tile[(kc + 6) * 65 + n], tile[(kc + 7) * 65 + n]);
        *(u32x4*)(dst + (size_t)(n0 + n) * ldk + k0 + kc) = o;
    }
    __syncthreads();
}

__device__ void transpose_strip(const float* __restrict__ src, int ldn, bf16_t* __restrict__ dst, int ldk, int k0, int n0, char* lds) {
    float* tile = (float*)lds;
    const int tid = threadIdx.x;
    f32x4 v[8];
#pragma unroll
    for (int ps = 0; ps < 8; ++ps) v[ps] = *(const f32x4*)(src + (size_t)(k0 + (tid >> 6) + ps * 8) * ldn + n0 + (tid & 63) * 4);
#pragma unroll
    for (int ps = 0; ps < 8; ++ps) {
        float* t = tile + ((tid >> 6) + ps * 8) * 257 + (tid & 63) * 4;
        t[0] = v[ps][0]; t[1] = v[ps][1]; t[2] = v[ps][2]; t[3] = v[ps][3];
    }
    __syncthreads();
#pragma unroll
    for (int ps = 0; ps < 4; ++ps) {
        const int n = (tid >> 3) + ps * 64, kc = (tid & 7) * 8;
        u32x4 o;
        o[0] = cvt_pk_bf16(tile[(kc + 0) * 257 + n], tile[(kc + 1) * 257 + n]);
        o[1] = cvt_pk_bf16(tile[(kc + 2) * 257 + n], tile[(kc + 3) * 257 + n]);
        o[2] = cvt_pk_bf16(tile[(kc + 4) * 257 + n], tile[(kc + 5) * 257 + n]);
        o[3] = cvt_pk_bf16(tile[(kc + 6) * 257 + n], tile[(kc + 7) * 257 + n]);
        *(u32x4*)(dst + (size_t)(n0 + n) * ldk + k0 + kc) = o;
    }
    __syncthreads();
}

__device__ void phase_prep(const Params& p, char* lds) {
    const int tid = threadIdx.x, lane = tid & 63, wid = __builtin_amdgcn_readfirstlane(tid >> 6);
    constexpr int N_TR = 320, N_ROW = NTOK / 16;
    for (int item = blockIdx.x; item < N_TR + N_ROW; item += gridDim.x) {
        int t = item;
        if (t < N_TR) { transpose_strip(p.in[6], 5120, (bf16_t*)(p.ws + OFF_WTIN), 1024, (t / 20) * 64, (t % 20) * 256, lds); continue; }
#if 0
            if (t < 16) { transpose_strip(p.in[15], 512, (bf16_t*)(p.ws + OFF_WTGLU), 512, (t / 2) * 64, (t % 2) * 256, lds); continue; }
            t -= 16;
            if (t < 32) { transpose_strip(p.in[24], 1024, (bf16_t*)(p.ws + OFF_WTPA), 512, (t / 4) * 64, (t % 4) * 256, lds); continue; }
            t -= 32;
            if (t < 64) { transpose_strip(p.in[25], 1024, (bf16_t*)(p.ws + OFF_WTPB), 1024, (t / 4) * 64, (t % 4) * 256, lds); continue; }
            t -= 64;
            if (t < 64) { transpose_strip(p.in[26], 1024, (bf16_t*)(p.ws + OFF_WTOUT), 1024, (t / 4) * 64, (t % 4) * 256, lds); continue; }
            t -= 64;
#endif
        t -= N_TR;
        {
            const int tok0 = t * 16 + wid * 2;
            f32x4 v[2][4]; float ss[2] = {0.f, 0.f};
#pragma unroll
            for (int rr = 0; rr < 2; ++rr) {
                const float* x = xrow(p, tok0 + rr) + lane * 16;
#pragma unroll
                for (int i = 0; i < 4; ++i) v[rr][i] = *(const f32x4*)(x + i * 4);
            }
            const float* gp = p.in[5] + lane * 16;
            const f32x4 g0 = *(const f32x4*)(gp), g1 = *(const f32x4*)(gp + 4), g2 = *(const f32x4*)(gp + 8), g3 = *(const f32x4*)(gp + 12);
#pragma unroll
            for (int rr = 0; rr < 2; ++rr) {
#pragma unroll
                for (int i = 0; i < 4; ++i) ss[rr] += v[rr][i][0] * v[rr][i][0] + v[rr][i][1] * v[rr][i][1] + v[rr][i][2] * v[rr][i][2] + v[rr][i][3] * v[rr][i][3];
#pragma unroll
                for (int o = 32; o; o >>= 1) ss[rr] += __shfl_xor(ss[rr], o);
                const float rs = rsqrtf(ss[rr] * (1.f / 1024.f) + 1e-6f);
                u32x4 o0, o1;
                o0[0] = cvt_pk_bf16(v[rr][0][0] * rs * g0[0], v[rr][0][1] * rs * g0[1]); o0[1] = cvt_pk_bf16(v[rr][0][2] * rs * g0[2], v[rr][0][3] * rs * g0[3]);
                o0[2] = cvt_pk_bf16(v[rr][1][0] * rs * g1[0], v[rr][1][1] * rs * g1[1]); o0[3] = cvt_pk_bf16(v[rr][1][2] * rs * g1[2], v[rr][1][3] * rs * g1[3]);
                o1[0] = cvt_pk_bf16(v[rr][2][0] * rs * g2[0], v[rr][2][1] * rs * g2[1]); o1[1] = cvt_pk_bf16(v[rr][2][2] * rs * g2[2], v[rr][2][3] * rs * g2[3]);
                o1[2] = cvt_pk_bf16(v[rr][3][0] * rs * g3[0], v[rr][3][1] * rs * g3[1]); o1[3] = cvt_pk_bf16(v[rr][3][2] * rs * g3[2], v[rr][3][3] * rs * g3[3]);
                bf16_t* xn = (bf16_t*)(p.ws + OFF_REGA) + (size_t)(tok0 + rr) * 1024 + lane * 16;
                *(u32x4*)xn = o0; *(u32x4*)(xn + 8) = o1;
            }
        }
    }
}

namespace pg8 {
#define PG8_LAS __attribute__((address_space(3)))
typedef unsigned short bf16_t;
typedef short bf16x8 __attribute__((ext_vector_type(8)));
typedef float f32x4 __attribute__((ext_vector_type(4)));
typedef unsigned u32x4 __attribute__((ext_vector_type(4)));
constexpr int BM = 256, BK = 64, HALF = 128, HTB = HALF * BK * 2  , STAGE_BYTES = 8 * HTB, NXCD = 8, WGM = 8;

__host__ __device__ __forceinline__ int lds_byte(int r, int c) { const int st = (r >> 4) * 2 + (c >> 5), rr = r & 15, cc = c & 31, ob = rr * 64 + cc * 2; return st * 1024 + (ob ^ (((ob >> 9) & 1) << 5)); }
__host__ __device__ __forceinline__ void stage_rc(int b, int& R, int& C) { const int st = b / 1024, sb = b % 1024, swz = sb ^ (((sb >> 9) & 1) << 5); R = (st >> 1) * 16 + swz / 64; C = (st & 1) * 32 + (swz % 64) / 2; }
__host__ __device__ __forceinline__ int perm32(int rho) { const int n = rho >> 4, i = rho & 15; return 8 * (i >> 2) + 4 * n + (i & 3); }

struct Unit { int pm, pn; };
struct Gemm { const bf16_t* A; const bf16_t* Bt; int M, N, K; };

struct StaticOrder {
    int nM, nN, nwg, G, c;
    __host__ __device__ void init(int M, int N, int G_, int c_) { nM = M / BM; nN = N / BM; nwg = nM * nN; G = G_; c = c_; }
    __host__ __device__ bool next(int i, Unit& u) const {
        const long L = (long)i * G + c; if (L >= nwg) return false;
        int wgid = (int)L; { const int q = nwg / NXCD, r = nwg % NXCD, xcd = wgid % NXCD, off = wgid / NXCD; wgid = (xcd < r ? xcd * (q + 1) : r * (q + 1) + (xcd - r) * q) + off; }
        const int nig = WGM * nN, gid = wgid / nig, fm = gid * WGM, gsz = (nM - fm) < WGM ? (nM - fm) : WGM;
        u.pm = fm + ((wgid % nig) % gsz); u.pn = (wgid % nig) / gsz; return true;
    }
    __device__ __forceinline__ void a_ready(const Unit&) const {}
    __device__ __forceinline__ void done(const Unit&) const {}
};

template <class Epi, class Sched, bool ALIGN_EPI = false, bool SP2 = false>
__device__ __forceinline__ void gemm_phase(PG8_LAS unsigned char* lds, const Gemm g, const Sched& S, const Epi& E) {
    const int tid = threadIdx.x, wid = __builtin_amdgcn_readfirstlane(tid >> 6), lane = tid & 63, wr = wid >> 2, wc = wid & 3, fr = lane & 15, fq = lane >> 4;
    const int K = g.K, nt = K / BK;
    unsigned voffA[2], voffB[2];
#pragma unroll
    for (int i = 0; i < 2; ++i) { int R, C; stage_rc(tid * 16 + i * 8192, R, C); const int Rb = Epi::PERM ? ((R & ~31) + perm32(R & 31)) : R;
        voffA[i] = (unsigned)(R * K + C) * 2u; voffB[i] = (unsigned)(Rb * K + C) * 2u; }
    const size_t kstep = (size_t)(BK * 2);
    const size_t hstep = (size_t)HALF * K * 2;
    const size_t tstep = 2 * hstep;
    const unsigned ldsw = (unsigned)wid * 1024u;
    const unsigned lds_u32 = (unsigned)(size_t)lds;
    const int aoff = lds_byte(wr * 64 + fr, fq * 8), boff = lds_byte(wc * 32 + fr, fq * 8);
#define PG8_SA(b, h) (((b) * 2 + (h)) * HTB)
#define PG8_SB(b, h) ((4 + (b) * 2 + (h)) * HTB)
#define PG8_STAGE(bufoff, gbase, voff) do { _Pragma("unroll") for (int _i = 0; _i < 2; ++_i) \
        glds16_asm((const char*)(gbase) + (voff)[_i], lds_u32 + (unsigned)(bufoff) + ldsw + (unsigned)(_i * 8192)); } while (0)
#define PG8_LDA(dst, b, h) do { _Pragma("unroll") for (int m = 0; m < 4; ++m) _Pragma("unroll") for (int k = 0; k < 2; ++k) dst[m][k] = *(const PG8_LAS bf16x8*)(lds + PG8_SA(b, h) + aoff + m * 2048 + k * 1024); } while (0)
#define PG8_LDB(dst, b, h) do { _Pragma("unroll") for (int n = 0; n < 2; ++n) _Pragma("unroll") for (int k = 0; k < 2; ++k) dst[n][k] = *(const PG8_LAS bf16x8*)(lds + PG8_SB(b, h) + boff + n * 2048 + k * 1024); } while (0)
#define PG8_MMA(ai, bj, At, Bt) do { __builtin_amdgcn_s_setprio(1); _Pragma("unroll") for (int m = 0; m < 4; ++m) _Pragma("unroll") for (int n = 0; n < 2; ++n) _Pragma("unroll") for (int k = 0; k < 2; ++k) \
        acc[ai][bj][m][n] = __builtin_amdgcn_mfma_f32_16x16x32_bf16(Bt[n][k], At[m][k], acc[ai][bj][m][n], 0, 0, 0); __builtin_amdgcn_s_setprio(0); } while (0)
#define PG8_WAIT_V(n) asm volatile("s_waitcnt vmcnt(" #n ")" ::: "memory")
#define PG8_WAIT_L(n) asm volatile("s_waitcnt lgkmcnt(" #n ")" ::: "memory")
#define PG8_BAR __builtin_amdgcn_s_barrier()
#define PG8_SCHED __builtin_amdgcn_sched_barrier(0)
    Unit cur, nxt; int ui = 0;
    if (!S.next(0, cur)) return;
    f32x4 acc[2][2][4][2];
#pragma unroll
    for (int a = 0; a < 2; ++a)
#pragma unroll
        for (int b = 0; b < 2; ++b)
#pragma unroll
            for (int m = 0; m < 4; ++m)
#pragma unroll
                for (int n = 0; n < 2; ++n) acc[a][b][m][n] = (f32x4){0.f, 0.f, 0.f, 0.f};
    bf16x8 At[4][2], B0[2][2], B1[2][2];
    const char* cA = (const char*)g.A + (size_t)cur.pm * tstep; const char* cB = (const char*)g.Bt + (size_t)cur.pn * tstep;
    S.a_ready(cur);
    if constexpr (SP2) {
        PG8_STAGE(PG8_SB(0, 0), cB, voffB); PG8_STAGE(PG8_SB(0, 1), cB + hstep, voffB); PG8_STAGE(PG8_SA(0, 0), cA, voffA); PG8_STAGE(PG8_SA(0, 1), cA + hstep, voffA);
        if (wr == 1) PG8_BAR;
        PG8_WAIT_V(2); PG8_BAR;
        PG8_STAGE(PG8_SB(1, 0), cB + kstep, voffB); PG8_STAGE(PG8_SA(1, 0), cA + kstep, voffA); PG8_STAGE(PG8_SB(1, 1), cB + hstep + kstep, voffB);
        PG8_WAIT_V(6); PG8_BAR;
    } else {
        PG8_STAGE(PG8_SB(0, 0), cB, voffB); PG8_STAGE(PG8_SA(0, 0), cA, voffA); PG8_STAGE(PG8_SB(0, 1), cB + hstep, voffB); PG8_STAGE(PG8_SA(0, 1), cA + hstep, voffA);
        if (wr == 1) PG8_BAR;
        PG8_WAIT_V(4); PG8_BAR;
        PG8_STAGE(PG8_SB(1, 0), cB + kstep, voffB); PG8_STAGE(PG8_SA(1, 0), cA + kstep, voffA); PG8_STAGE(PG8_SB(1, 1), cB + hstep + kstep, voffB);
        PG8_WAIT_V(6); PG8_BAR;
    }
    for (;;) {
        const bool has_next = S.next(ui + 1, nxt);
        const char* nA = has_next ? (const char*)g.A + (size_t)nxt.pm * tstep : cA; const char* nB = has_next ? (const char*)g.Bt + (size_t)nxt.pn * tstep : cB;
        for (int t = 0; t < nt; t += 2) {
            const bool last = (t == nt - 2);
            const char* a1 = cA + (size_t)(t + 1) * kstep;
            const char* a2 = last ? nA : cA + (size_t)(t + 2) * kstep; const char* b2 = last ? nB : cB + (size_t)(t + 2) * kstep;
            const char* a3 = a2 + kstep; const char* b3 = b2 + kstep;
            if (last && has_next) S.a_ready(nxt);
            if constexpr (SP2) {
            PG8_LDB(B0, 0, 0); PG8_LDB(B1, 0, 1); PG8_SCHED; PG8_LDA(At, 0, 0); PG8_STAGE(PG8_SA(1, 1), a1 + hstep, voffA);
            PG8_WAIT_V(8); PG8_WAIT_L(0); PG8_BAR; PG8_MMA(0, 0, At, B0); PG8_MMA(0, 1, At, B1); PG8_BAR; PG8_SCHED;
            PG8_LDA(At, 0, 1); PG8_STAGE(PG8_SB(0, 0), b2, voffB); PG8_STAGE(PG8_SB(0, 1), b2 + hstep, voffB); PG8_STAGE(PG8_SA(0, 0), a2, voffA);
            PG8_WAIT_V(8); PG8_WAIT_L(0); PG8_BAR; PG8_MMA(1, 0, At, B0); PG8_MMA(1, 1, At, B1); PG8_BAR; PG8_SCHED;
            PG8_LDB(B0, 1, 0); PG8_LDB(B1, 1, 1); PG8_SCHED; PG8_LDA(At, 1, 0); PG8_STAGE(PG8_SA(0, 1), a2 + hstep, voffA);
            PG8_WAIT_V(8); PG8_WAIT_L(0); PG8_BAR; PG8_MMA(0, 0, At, B0); PG8_MMA(0, 1, At, B1); PG8_BAR; PG8_SCHED;
            PG8_LDA(At, 1, 1); PG8_STAGE(PG8_SB(1, 0), b3, voffB); PG8_STAGE(PG8_SB(1, 1), b3 + hstep, voffB); PG8_STAGE(PG8_SA(1, 0), a3, voffA);
            PG8_WAIT_V(8); PG8_WAIT_L(0); PG8_BAR; PG8_MMA(1, 0, At, B0); PG8_MMA(1, 1, At, B1); PG8_BAR; PG8_SCHED;
            } else {
            PG8_LDB(B0, 0, 0); PG8_SCHED; PG8_LDA(At, 0, 0); PG8_STAGE(PG8_SA(1, 1), a1 + hstep, voffA);
            PG8_WAIT_L(8); PG8_BAR; PG8_WAIT_L(0); PG8_MMA(0, 0, At, B0); PG8_BAR; PG8_SCHED;
            PG8_LDB(B1, 0, 1); PG8_STAGE(PG8_SB(0, 0), b2, voffB);
            PG8_BAR; PG8_WAIT_L(0); PG8_MMA(0, 1, At, B1); PG8_BAR;
            PG8_LDA(At, 0, 1); PG8_STAGE(PG8_SA(0, 0), a2, voffA);
            PG8_BAR; PG8_WAIT_L(0); PG8_MMA(1, 0, At, B0); PG8_BAR; PG8_SCHED;
            PG8_STAGE(PG8_SB(0, 1), b2 + hstep, voffB);
            PG8_WAIT_V(6); PG8_BAR; PG8_MMA(1, 1, At, B1); PG8_BAR;
            PG8_LDB(B0, 1, 0); PG8_SCHED; PG8_LDA(At, 1, 0); PG8_STAGE(PG8_SA(0, 1), a2 + hstep, voffA);
            PG8_WAIT_L(8); PG8_BAR; PG8_WAIT_L(0); PG8_MMA(0, 0, At, B0); PG8_BAR; PG8_SCHED;
            PG8_LDB(B1, 1, 1); PG8_STAGE(PG8_SB(1, 0), b3, voffB);
            PG8_BAR; PG8_WAIT_L(0); PG8_MMA(0, 1, At, B1); PG8_BAR;
            PG8_LDA(At, 1, 1); PG8_STAGE(PG8_SA(1, 0), a3, voffA);
            PG8_BAR; PG8_WAIT_L(0); PG8_MMA(1, 0, At, B0); PG8_BAR; PG8_SCHED;
            PG8_STAGE(PG8_SB(1, 1), b3 + hstep, voffB);
            PG8_WAIT_V(6); PG8_BAR; PG8_MMA(1, 1, At, B1); PG8_BAR;
            }
        }
        if constexpr (ALIGN_EPI) { if (wr == 0) PG8_BAR; }
        if constexpr (!Epi::AFTER_DRAIN) { E(acc, cur, wr, wc, fr, fq); S.done(cur); }
        if (!has_next) break;
#pragma unroll
        for (int a = 0; a < 2; ++a)
#pragma unroll
            for (int b = 0; b < 2; ++b)
#pragma unroll
                for (int m = 0; m < 4; ++m)
#pragma unroll
                    for (int n = 0; n < 2; ++n) acc[a][b][m][n] = (f32x4){0.f, 0.f, 0.f, 0.f};
        cur = nxt; cA = nA; cB = nB; ++ui;
        if constexpr (ALIGN_EPI) { if (wr == 1) PG8_BAR; }
    }
    PG8_WAIT_V(0);
    if constexpr (!ALIGN_EPI) { if (wr == 0) PG8_BAR; }
    PG8_BAR;
    if constexpr (Epi::AFTER_DRAIN) { E.fused(acc, cur, wr, wc, fr, fq, lds, wid, lane); S.done(cur); }
#undef PG8_SA
#undef PG8_SB
#undef PG8_STAGE
#undef PG8_LDA
#undef PG8_LDB
#undef PG8_MMA
#undef PG8_WAIT_V
#undef PG8_WAIT_L
#undef PG8_BAR
#undef PG8_SCHED
}
}

template <class F> struct Epi8 {
    static constexpr bool PERM = true, AFTER_DRAIN = false; F f;
    __device__ __forceinline__ void operator()(const f32x4 (&acc)[2][2][4][2], const pg8::Unit& u, int wr, int wc, int fr, int fq) const {
        const int row0 = u.pm * 256 + wr * 64 + fr, col0 = u.pn * 256 + wc * 32 + 8 * fq;
#pragma unroll
        for (int ai = 0; ai < 2; ++ai)
#pragma unroll
            for (int m = 0; m < 4; ++m) {
#pragma unroll
                for (int bj = 0; bj < 2; ++bj) { f(row0 + ai * 128 + m * 16, col0 + bj * 128, acc[ai][bj][m][0], acc[ai][bj][m][1]); __builtin_amdgcn_sched_barrier(0); }
            }
    }
};
template <class F> struct Epi4 {
    static constexpr bool PERM = false, AFTER_DRAIN = false; F f;
    __device__ __forceinline__ void operator()(const f32x4 (&acc)[2][2][4][2], const pg8::Unit& u, int wr, int wc, int fr, int fq) const {
        const int row0 = u.pm * 256 + wr * 64 + fr, col0 = u.pn * 256 + wc * 32 + 4 * fq;
#pragma unroll
        for (int ai = 0; ai < 2; ++ai)
#pragma unroll
            for (int m = 0; m < 4; ++m) {
#pragma unroll
                for (int bj = 0; bj < 2; ++bj)
#pragma unroll
                    for (int n = 0; n < 2; ++n) f(row0 + ai * 128 + m * 16, col0 + bj * 128 + n * 16, acc[ai][bj][m][n]);
                __builtin_amdgcn_sched_barrier(0);
            }
    }
};
template <class E> __device__ __forceinline__ void run_gemm256(char* lds, const bf16_t* A, const bf16_t* Bt, int M, int N, int K, const E& e, int cshift = 0) {
    pg8::Gemm g{A, Bt, M, N, K};
    pg8::StaticOrder S; S.init(M, N, (int)gridDim.x, (int)((blockIdx.x + gridDim.x - cshift) % gridDim.x));
    pg8::gemm_phase<E, pg8::StaticOrder, !E::AFTER_DRAIN, true>((PG8_LAS unsigned char*)lds, g, S, e);
}
__device__ __forceinline__ u32x4 pack8(const f32x4& a, const f32x4& b) {
    u32x4 o; o[0] = cvt_pk_bf16(a[0], a[1]); o[1] = cvt_pk_bf16(a[2], a[3]); o[2] = cvt_pk_bf16(b[0], b[1]); o[3] = cvt_pk_bf16(b[2], b[3]); return o;
}

struct EpiG1 {
    static constexpr bool PERM = true, AFTER_DRAIN = false;
    bf16_t *uax, *sza, *ub, *szb, *sg; float* out;
    __device__ __forceinline__ void operator()(const f32x4 (&acc)[2][2][4][2], const pg8::Unit& u, int wr, int wc, int fr, int fq) const {
        const int row0 = u.pm * 256 + wr * 64 + fr, col0 = u.pn * 256 + wc * 32 + 8 * fq, colt = u.pn * 256;
#pragma unroll
        for (int ai = 0; ai < 2; ++ai)
#pragma unroll
            for (int m = 0; m < 4; ++m) {
                const int r = row0 + ai * 128 + m * 16;
#pragma unroll
                for (int bj = 0; bj < 2; ++bj) {
                    const int c = col0 + bj * 128;
                    const f32x4 v0 = acc[ai][bj][m][0], v1 = acc[ai][bj][m][1];
                    if (colt < 512) {
                        const int g = c >> 4, co = c & 15, n = r >> 4, t = r & 15;
                        *(u32x4*)(uax + ((size_t)g * NSUBP + n) * 384 + t * 16 + co) = pack8(v0, v1);
                    } else if (colt < 1024) {
                        f32x4 a, b;
#pragma unroll
                        for (int j = 0; j < 4; ++j) { a[j] = silu(v0[j]); b[j] = silu(v1[j]); }
                        *(u32x4*)(sza + (size_t)r * 512 + (c - 512)) = pack8(a, b);
                    } else if (colt < 2048) {
                        const int ch = c - 1024;
                        *(u32x4*)(ub + (size_t)r * 1024 + ch) = pack8(v0, v1);
                        if (r < NPTOK) { const int tau = r & 2047; if (tau >= 2045) { float* o = out + O_CONVP + ((size_t)(r >> 11) * 3 + (tau - 2045)) * 1024 + ch; *(f32x4*)o = v0; *(f32x4*)(o + 4) = v1; } }
                        else { const int q = r - NPTOK, tau = q & 15; if (tau >= 13) { float* o = out + O_CONVS + ((size_t)(q >> 4) * 3 + (tau - 13)) * 1024 + ch; *(f32x4*)o = v0; *(f32x4*)(o + 4) = v1; } }
                    } else if (colt < 3072) {
                        f32x4 a, b;
#pragma unroll
                        for (int j = 0; j < 4; ++j) { a[j] = silu(v0[j]); b[j] = silu(v1[j]); }
                        *(u32x4*)(szb + (size_t)r * 1024 + (c - 2048)) = pack8(a, b);
                    } else {
                        f32x4 a, b;
#pragma unroll
                        for (int j = 0; j < 4; ++j) { a[j] = sigm(v0[j]); b[j] = sigm(v1[j]); }
                        *(u32x4*)(sg + (size_t)r * 2048 + (c - 3072)) = pack8(a, b);
                    }
                }
                __builtin_amdgcn_sched_barrier(0);
            }
    }
};
__device__ void prep_deferred(const Params& p, char* lds, int first, int nwg) {
    for (int item = (int)blockIdx.x - first; item < 128 + 176 + 32; item += nwg) {
        if (item < 128) { s5_tables(p, item >> 2, item & 3, lds); continue; }
        int t = item - 128;
        if (t < 16) { transpose_strip(p.in[15], 512, (bf16_t*)(p.ws + OFF_WTGLU), 512, (t / 2) * 64, (t % 2) * 256, lds); continue; }
        t -= 16;
        if (t < 32) { transpose_strip(p.in[24], 1024, (bf16_t*)(p.ws + OFF_WTPA), 512, (t / 4) * 64, (t % 4) * 256, lds); continue; }
        t -= 32;
        if (t < 64) { transpose_strip(p.in[25], 1024, (bf16_t*)(p.ws + OFF_WTPB), 1024, (t / 4) * 64, (t % 4) * 256, lds); continue; }
        t -= 64;
        if (t < 64) { transpose_strip(p.in[26], 1024, (bf16_t*)(p.ws + OFF_WTOUT), 1024, (t / 4) * 64, (t % 4) * 256, lds); continue; }
        t -= 64;
        { const int hd = t >> 1, which = t & 1;
          transpose_tile(p.in[which ? 21 : 19] + hd * 4096, 64, (bf16_t*)(p.ws + OFF_WTG) + (hd * 128 + which * 64) * 64, 64, 0, 0, lds); }
    }
}
__device__ void phase_gemm1(const Params& p, char* lds) {
    EpiG1 e{(bf16_t*)(p.ws + OFF_UAX), (bf16_t*)(p.ws + OFF_SZA), (bf16_t*)(p.ws + OFF_REGB), (bf16_t*)(p.ws + OFF_SZB), (bf16_t*)(p.out + O_Y), p.out};
    run_gemm256(lds, (const bf16_t*)(p.ws + OFF_REGA), (const bf16_t*)(p.ws + OFF_WTIN), NTOK, 5120, 1024, e);
    if (blockIdx.x >= 40) prep_deferred(p, lds, 40, (int)gridDim.x - 40);
}

struct LruConsts { bf16x8 br[2], bi[2]; f32x4 ba, bx, sp8; };
__device__ __forceinline__ void lru_load_consts(const Params& p, int hd, LruConsts& c) {
    const int tid = threadIdx.x, lane = tid & 63, wid = __builtin_amdgcn_readfirstlane(tid >> 6), fr = lane & 15, fq = lane >> 4;
    const int cb = wid & 3;
    const bf16_t* wg = (const bf16_t*)(p.ws + OFF_WTG) + (size_t)hd * 128 * 64;
#pragma unroll
    for (int ks = 0; ks < 2; ++ks) {
        c.br[ks] = *(const bf16x8*)(wg + (cb * 16 + fr) * 64 + ks * 32 + fq * 8);
        c.bi[ks] = *(const bf16x8*)(wg + (64 + cb * 16 + fr) * 64 + ks * 32 + fq * 8);
    }
    const int ch = hd * 64 + cb * 16 + fq * 4;
    c.ba = *(const f32x4*)(p.in[20] + ch); c.bx = *(const f32x4*)(p.in[22] + ch);
    const f32x4 lam = *(const f32x4*)(p.in[23] + ch);
#pragma unroll
    for (int j = 0; j < 4; ++j) c.sp8[j] = 8.f * log1pf(expf(-lam[j]));
}
struct LruRaw { u32x4 v[2][4]; };
__device__ __forceinline__ void lru_fetch(const Params& p, int tt, int hd, LruRaw& r) {
    const int tid = threadIdx.x;
    const bf16_t* ub = (const bf16_t*)(p.ws + OFF_REGB);
#pragma unroll
    for (int ps = 0; ps < 2; ++ps) {
        const int t = (tid >> 3) + ps * 64, c8 = tid & 7, tok = tt * 128 + t, ch0 = hd * 64 + c8 * 8;
        int tau, seq; const bool smp = tok >= NPTOK;
        if (!smp) { tau = tok & 2047; seq = tok >> 11; } else { tau = (tok - NPTOK) & 15; seq = (tok - NPTOK) >> 4; }
#pragma unroll
        for (int k = 0; k < 4; ++k) {
            const int st = tau + k - 3;
            if (st >= 0) r.v[ps][k] = *(const u32x4*)(ub + (size_t)(tok + k - 3) * 1024 + ch0);
            else if (smp) {
                const float* sp = p.in[4] + ((size_t)seq * 3 + (tau + k)) * 1024 + ch0;
                const f32x4 s0 = *(const f32x4*)sp, s1 = *(const f32x4*)(sp + 4);
                r.v[ps][k] = (u32x4){cvt_pk_bf16(s0[0], s0[1]), cvt_pk_bf16(s0[2], s0[3]), cvt_pk_bf16(s1[0], s1[1]), cvt_pk_bf16(s1[2], s1[3])};
            } else r.v[ps][k] = (u32x4){0u, 0u, 0u, 0u};
        }
    }
}
__device__ void lru_local_item(const Params& p, int tt, int hd, char* lds, const LruConsts& kc, const LruRaw& raw, LruRaw& nxt, int tt_next) {
    const int tid = threadIdx.x, lane = tid & 63, wid = __builtin_amdgcn_readfirstlane(tid >> 6), fr = lane & 15, fq = lane >> 4;
    char* sA = lds;
    float* xg = (float*)(lds + 16384);
    float* af = xg + 128 * 68;
    const bf16_t* ub = (const bf16_t*)(p.ws + OFF_REGB);
#pragma unroll
    for (int ps = 0; ps < 2; ++ps) {
        const int t = (tid >> 3) + ps * 64, c8 = tid & 7, ch0 = hd * 64 + c8 * 8;
        float xc[8];
        { const f32x4 b0 = *(const f32x4*)(p.in[18] + ch0), b1 = *(const f32x4*)(p.in[18] + ch0 + 4);
          xc[0] = b0[0]; xc[1] = b0[1]; xc[2] = b0[2]; xc[3] = b0[3]; xc[4] = b1[0]; xc[5] = b1[1]; xc[6] = b1[2]; xc[7] = b1[3]; }
#pragma unroll
        for (int k = 0; k < 4; ++k) {
            const u32x4 w = raw.v[ps][k];
            const f32x4 w0 = *(const f32x4*)(p.in[17] + k * 1024 + ch0), w1 = *(const f32x4*)(p.in[17] + k * 1024 + ch0 + 4);
            xc[0] += w0[0] * bflo(w[0]); xc[1] += w0[1] * bfhi(w[0]); xc[2] += w0[2] * bflo(w[1]); xc[3] += w0[3] * bfhi(w[1]);
            xc[4] += w1[0] * bflo(w[2]); xc[5] += w1[1] * bfhi(w[2]); xc[6] += w1[2] * bflo(w[3]); xc[7] += w1[3] * bfhi(w[3]);
        }
        u32x4 o; o[0] = cvt_pk_bf16(xc[0], xc[1]); o[1] = cvt_pk_bf16(xc[2], xc[3]); o[2] = cvt_pk_bf16(xc[4], xc[5]); o[3] = cvt_pk_bf16(xc[6], xc[7]);
        *(u32x4*)(sA + t * 128 + ((c8 ^ ((t >> 1) & 7)) * 16)) = o;
        *(f32x4*)(xg + t * 68 + c8 * 8) = (f32x4){xc[0], xc[1], xc[2], xc[3]};
        *(f32x4*)(xg + t * 68 + c8 * 8 + 4) = (f32x4){xc[4], xc[5], xc[6], xc[7]};
    }
    if (tt_next >= 0) lru_fetch(p, tt_next, hd, nxt);
    __syncthreads();
    {
        const int cb = wid & 3, th = wid >> 2;
        const int chl = cb * 16 + fq * 4;
        const bf16x8 br[2] = {kc.br[0], kc.br[1]}, bi[2] = {kc.bi[0], kc.bi[1]};
        const f32x4 ba = kc.ba, bx = kc.bx, sp8 = kc.sp8;
#pragma unroll
        for (int mb = 0; mb < 4; ++mb) {
            const int t = th * 64 + mb * 16 + fr;
            f32x4 ar = {0.f, 0.f, 0.f, 0.f}, ai = {0.f, 0.f, 0.f, 0.f};
#pragma unroll
            for (int ks = 0; ks < 2; ++ks) {
                const bf16x8 a = *(const bf16x8*)(sA + t * 128 + (((ks * 4 + fq) ^ ((t >> 1) & 7)) * 16));
                ar = __builtin_amdgcn_mfma_f32_16x16x32_bf16(br[ks], a, ar, 0, 0, 0);
                ai = __builtin_amdgcn_mfma_f32_16x16x32_bf16(bi[ks], a, ai, 0, 0, 0);
            }
            const f32x4 xc = *(const f32x4*)(xg + t * 68 + chl);
            f32x4 av, gv;
#pragma unroll
            for (int j = 0; j < 4; ++j) {
                const float r = sigm(ar[j] + ba[j]), ig = sigm(ai[j] + bx[j]);
                float la = -sp8[j] * r;
                const float a = __expf(la), x2 = 2.f * la;
                const float om = (x2 > -0.1f) ? -x2 * (1.f + x2 * (0.5f + x2 * (0.16666667f + x2 * 0.041666668f))) : 1.f - a * a;
                av[j] = a; gv[j] = __builtin_amdgcn_sqrtf(fmaxf(om, 0.f)) * ig * xc[j];
            }
            *(f32x4*)(af + t * 68 + chl) = av;
            *(f32x4*)(xg + t * 68 + chl) = gv;
        }
    }
    __syncthreads();
    {
        const int sc = tid >> 6, chl = tid & 63, ch = hd * 64 + chl;
        bf16_t* hl = (bf16_t*)(p.ws + OFF_REGC);
        bf16_t* pb = (bf16_t*)(p.ws + OFF_REGA);
        float h = 0.f, P = 1.f;
#pragma unroll
        for (int s = 0; s < 16; ++s) {
            const int t = sc * 16 + s;
            const float a = af[t * 68 + chl], g = xg[t * 68 + chl];
            h = a * h + g; P *= a;
            const size_t o = (size_t)(tt * 128 + t) * 1024 + ch;
            hl[o] = f2bf(h); pb[o] = f2bf(P);
        }
        const size_t n = (size_t)tt * 8 + sc;
        ((float*)(p.ws + OFF_PEND))[n * 1024 + ch] = P;
        ((float*)(p.ws + OFF_HEND))[n * 1024 + ch] = h;
    }
    __syncthreads();
}

__device__ void phase_m1(const Params& p, char* lds) {
    constexpr int N_SE = 32 * 5, N_LRU = (NTOK / 128) * 16;
    const int bx = blockIdx.x;
    if (bx < N_SE) {
        const int g = bx / 5, mt = bx % 5;
        f32x4 acc[4][4]; zero_acc(acc);
        gemm_acc<4, 2>(acc, (const bf16_t*)(p.ws + OFF_UAX) + (size_t)g * NSUBP * 384, 384,
                       (const bf16_t*)(p.ws + OFF_BTE) + (size_t)g * 128 * 256, 256, 256, mt * 256, 0, lds);
        float* se = (float*)(p.ws + OFF_SEND) + (size_t)g * NSUBP * 128;
        gemm_epi<4, 2>(acc, mt * 256, 0, [&](int r, int c, const f32x4& v) { if (r < NSUB) *(f32x4*)(se + (size_t)r * 128 + c) = v; });
    }
    int it = bx < N_SE ? bx + (256 - N_SE) : bx - N_SE;
    if (it < N_LRU) {
        const int hd = it & 15;
        LruConsts kc; lru_load_consts(p, hd, kc);
        LruRaw ra, rb;
        lru_fetch(p, it >> 4, hd, ra);
        for (;;) {
            int nx = it + 256;
            lru_local_item(p, it >> 4, hd, lds, kc, ra, rb, nx < N_LRU ? (nx >> 4) : -1);
            if (nx >= N_LRU) break;
            it = nx; nx = it + 256;
            lru_local_item(p, it >> 4, hd, lds, kc, rb, ra, nx < N_LRU ? (nx >> 4) : -1);
            if (nx >= N_LRU) break;
            it = nx;
        }
    }
}

__device__ void phase_m2(const Params& p) {
    const int tid = threadIdx.x, b = blockIdx.x;
    if (b < 128) {
        for (int pass = 0; pass < 2; ++pass) {
            const bool prompt = pass == 0;
            if (prompt && tid >= 128) continue;
            const int idx = prompt ? b * 128 + tid : b * 512 + tid;
            const int seq = idx >> 11, g = (idx >> 6) & 31, pi = idx & 63;
            float lr, li, cr, ci; s5_disc(p, g, pi, lr, li, cr, ci);
#pragma unroll
            for (int s = 0; s < 4; ++s) { const float nr = lr * lr - li * li, ni = 2.f * lr * li; lr = nr; li = ni; }
            const int n0 = prompt ? seq * 128 : 1024 + seq;
            float hr = 0.f, hi = 0.f;
            if (!prompt) { const f32x2 s0 = *(const f32x2*)(p.in[2] + (((size_t)seq * 32 + g) * 64 + pi) * 2); hr = s0[0]; hi = s0[1]; }
            const float* S = (const float*)(p.ws + OFF_SEND) + ((size_t)g * NSUBP + n0) * 128 + 2 * pi;
            bf16_t* H = (bf16_t*)(p.ws + OFF_UAX) + ((size_t)g * NSUBP + n0) * 384 + 256 + 2 * pi;
            if (prompt) {
                f32x2 sb[2][32];
#pragma unroll
                for (int j = 0; j < 32; ++j) sb[0][j] = *(const f32x2*)(S + (size_t)j * 128);
#pragma unroll
                for (int kb = 0; kb < 4; ++kb) {
                    if (kb + 1 < 4) {
#pragma unroll
                        for (int j = 0; j < 32; ++j) sb[(kb + 1) & 1][j] = *(const f32x2*)(S + (size_t)((kb + 1) * 32 + j) * 128);
                    }
                    __builtin_amdgcn_sched_barrier(0);
#pragma unroll
                    for (int j = 0; j < 32; ++j) {
                        *(unsigned*)(H + (size_t)(kb * 32 + j) * 384) = cvt_pk_bf16(hr, hi);
                        const float nr = lr * hr - li * hi + sb[kb & 1][j][0], ni = lr * hi + li * hr + sb[kb & 1][j][1]; hr = nr; hi = ni;
                    }
                    __builtin_amdgcn_sched_barrier(0);
                }
            } else {
                *(unsigned*)H = cvt_pk_bf16(hr, hi);
                const f32x2 sv = *(const f32x2*)S;
                const float nr = lr * hr - li * hi + sv[0], ni = lr * hi + li * hr + sv[1]; hr = nr; hi = ni;
            }
            float* o = p.out + (prompt ? O_S5P : O_S5S) + (((size_t)seq * 32 + g) * 64 + pi) * 2;
            *(f32x2*)o = (f32x2){hr, hi};
        }
    } else if (b < 192) {
        const int bb = b - 128;
        for (int pass = 0; pass < 2; ++pass) {
            const bool prompt = pass == 0;
            if (prompt && tid >= 128) continue;
            const int idx = prompt ? bb * 128 + tid : bb * 512 + tid;
            const int seq = idx >> 10, ch = idx & 1023;
            const int n0 = prompt ? seq * 128 : 1024 + seq;
            float h = prompt ? 0.f : p.in[3][(size_t)seq * 1024 + ch];
            const float* Pe = (const float*)(p.ws + OFF_PEND) + (size_t)n0 * 1024 + ch;
            const float* He = (const float*)(p.ws + OFF_HEND) + (size_t)n0 * 1024 + ch;
            float* Hi = (float*)(p.ws + OFF_HIN) + (size_t)n0 * 1024 + ch;
            if (prompt) {
                float pbuf[2][32], hbuf[2][32];
#pragma unroll
                for (int j = 0; j < 32; ++j) { pbuf[0][j] = Pe[(size_t)j * 1024]; hbuf[0][j] = He[(size_t)j * 1024]; }
#pragma unroll
                for (int kb = 0; kb < 4; ++kb) {
                    if (kb + 1 < 4) {
#pragma unroll
                        for (int j = 0; j < 32; ++j) { pbuf[(kb + 1) & 1][j] = Pe[(size_t)((kb + 1) * 32 + j) * 1024]; hbuf[(kb + 1) & 1][j] = He[(size_t)((kb + 1) * 32 + j) * 1024]; }
                    }
                    __builtin_amdgcn_sched_barrier(0);
#pragma unroll
                    for (int j = 0; j < 32; ++j) { Hi[(size_t)(kb * 32 + j) * 1024] = h; h = pbuf[kb & 1][j] * h + hbuf[kb & 1][j]; }
                    __builtin_amdgcn_sched_barrier(0);
                }
            } else {
                Hi[0] = h; h = Pe[0] * h + He[0];
            }
            p.out[(prompt ? O_LRUP : O_LRUS) + (size_t)seq * 1024 + ch] = h;
        }
    }
}

__device__ void phase_m3(const Params& p, char* lds) {
    constexpr int N_Y = 32 * 9, N_FIX = NTOK / 16;
    const int tid = threadIdx.x;
    const int bx = blockIdx.x;
    const int nstep = (bx >= 224) ? 2 : 1 + (N_FIX - bx + 223) / 224;
    for (int step = 0; step < nstep; ++step) {
        const int item = (step == 0) ? bx : (bx >= 224 ? 256 + (bx - 224) : N_Y + bx + (step - 1) * 224);
        if (item < N_Y) {
            const int g = item < 256 ? (item >> 3) : (item - 256), mt = item < 256 ? (item & 7) : 8;
            f32x4 acc[4][4]; zero_acc(acc);
            gemm_acc<2, 4>(acc, (const bf16_t*)(p.ws + OFF_UAX) + (size_t)g * NSUBP * 384, 384,
                           (const bf16_t*)(p.ws + OFF_BTY) + (size_t)g * 256 * 384, 384, 384, mt * 128, 0, lds);
            bf16_t* ya = (bf16_t*)(p.ws + OFF_REGB);
            gemm_epi<2, 4>(acc, mt * 128, 0, [&](int r, int c, const f32x4& v) {
                if (r < NSUB) {
                    const int t = c >> 4, co = c & 15;
                    u32x2 o; o[0] = cvt_pk_bf16(gelu_t(v[0]), gelu_t(v[1])); o[1] = cvt_pk_bf16(gelu_t(v[2]), gelu_t(v[3]));
                    *(u32x2*)(ya + ((size_t)r * 16 + t) * 512 + g * 16 + co) = o; } });
        } else {
            const int it = item - N_Y;
            u32x4 hl[4], pp[4], sz[4]; f32x4 h0[4], h1[4]; size_t off[4];
#pragma unroll
            for (int h = 0; h < 4; ++h) {
                const int v8 = it * 2048 + h * 512 + tid, tok = v8 >> 7, c0 = (v8 & 127) * 8;
                off[h] = (size_t)tok * 1024 + c0;
                hl[h] = __builtin_nontemporal_load((const u32x4*)((const bf16_t*)(p.ws + OFF_REGC) + off[h]));
                pp[h] = __builtin_nontemporal_load((const u32x4*)((const bf16_t*)(p.ws + OFF_REGA) + off[h]));
                sz[h] = __builtin_nontemporal_load((const u32x4*)((const bf16_t*)(p.ws + OFF_SZB) + off[h]));
                const float* hin = (const float*)(p.ws + OFF_HIN) + (size_t)(tok >> 4) * 1024 + c0;
                h0[h] = *(const f32x4*)hin; h1[h] = *(const f32x4*)(hin + 4);
            }
            __builtin_amdgcn_sched_barrier(0);
#pragma unroll
            for (int h = 0; h < 4; ++h) {
                u32x4 r;
                r[0] = cvt_pk_bf16((bflo(hl[h][0]) + bflo(pp[h][0]) * h0[h][0]) * bflo(sz[h][0]), (bfhi(hl[h][0]) + bfhi(pp[h][0]) * h0[h][1]) * bfhi(sz[h][0]));
                r[1] = cvt_pk_bf16((bflo(hl[h][1]) + bflo(pp[h][1]) * h0[h][2]) * bflo(sz[h][1]), (bfhi(hl[h][1]) + bfhi(pp[h][1]) * h0[h][3]) * bfhi(sz[h][1]));
                r[2] = cvt_pk_bf16((bflo(hl[h][2]) + bflo(pp[h][2]) * h1[h][0]) * bflo(sz[h][2]), (bfhi(hl[h][2]) + bfhi(pp[h][2]) * h1[h][1]) * bfhi(sz[h][2]));
                r[3] = cvt_pk_bf16((bflo(hl[h][3]) + bflo(pp[h][3]) * h1[h][2]) * bflo(sz[h][3]), (bfhi(hl[h][3]) + bfhi(pp[h][3]) * h1[h][3]) * bfhi(sz[h][3]));
                *(u32x4*)((bf16_t*)(p.ws + OFF_REGC) + off[h]) = r;
            }
        }
    }
}

__device__ __forceinline__ void g2_small_tile(const Params& p, char* lds, int mt, int nt) {
    const bf16_t* ya = (const bf16_t*)(p.ws + OFF_REGB);
    const bf16_t* sza = (const bf16_t*)(p.ws + OFF_SZA);
    bf16_t* va = (bf16_t*)(p.ws + OFF_SEND);
    const float* bg = p.in[16];
    {
        f32x4 acc[4][4]; zero_acc(acc);
        gemm_acc<2, 4>(acc, ya, 512, (const bf16_t*)(p.ws + OFF_WTGLU), 512, 512, mt * 128, nt * 256, lds);
        gemm_epi<2, 4>(acc, mt * 128, nt * 256, [&](int r, int c, const f32x4& v) {
            const u32x2 y = *(const u32x2*)(ya + (size_t)r * 512 + c), z = *(const u32x2*)(sza + (size_t)r * 512 + c);
            const f32x4 b = *(const f32x4*)(bg + c);
            u32x2 o;
            o[0] = cvt_pk_bf16(bflo(y[0]) * sigm(v[0] + b[0]) * bflo(z[0]), bfhi(y[0]) * sigm(v[1] + b[1]) * bfhi(z[0]));
            o[1] = cvt_pk_bf16(bflo(y[1]) * sigm(v[2] + b[2]) * bflo(z[1]), bfhi(y[1]) * sigm(v[3] + b[3]) * bfhi(z[1]));
            *(u32x2*)(va + (size_t)r * 512 + c) = o; });
    }
}

__device__ void phase_g2(const Params& p, char* lds) {
    const bf16_t* ya = (const bf16_t*)(p.ws + OFF_REGB);
    const bf16_t* sza = (const bf16_t*)(p.ws + OFF_SZA);
    bf16_t* va = (bf16_t*)(p.ws + OFF_SEND);
    const float* bg = p.in[16];
    auto f = [=](int r, int c, const f32x4& v0, const f32x4& v1) {
        const u32x4 y = *(const u32x4*)(ya + (size_t)r * 512 + c), z = *(const u32x4*)(sza + (size_t)r * 512 + c);
        const f32x4 b0 = *(const f32x4*)(bg + c), b1 = *(const f32x4*)(bg + c + 4);
        u32x4 o;
        o[0] = cvt_pk_bf16(bflo(y[0]) * sigm(v0[0] + b0[0]) * bflo(z[0]), bfhi(y[0]) * sigm(v0[1] + b0[1]) * bfhi(z[0]));
        o[1] = cvt_pk_bf16(bflo(y[1]) * sigm(v0[2] + b0[2]) * bflo(z[1]), bfhi(y[1]) * sigm(v0[3] + b0[3]) * bfhi(z[1]));
        o[2] = cvt_pk_bf16(bflo(y[2]) * sigm(v1[0] + b1[0]) * bflo(z[2]), bfhi(y[2]) * sigm(v1[1] + b1[1]) * bfhi(z[2]));
        o[3] = cvt_pk_bf16(bflo(y[3]) * sigm(v1[2] + b1[2]) * bflo(z[3]), bfhi(y[3]) * sigm(v1[3] + b1[3]) * bfhi(z[3]));
        *(u32x4*)(va + (size_t)r * 512 + c) = o; };
    Epi8<decltype(f)> e{f};
    run_gemm256(lds, ya, (const bf16_t*)(p.ws + OFF_WTGLU), NPTOK, 512, 512, e);
    { const int t = (int)blockIdx.x - 128; if (t >= 0 && t < 8) g2_small_tile(p, lds, 128 + (t >> 1), t & 1); }
}


struct EpiNorm {
    static constexpr bool PERM = false, AFTER_DRAIN = true;
    float* y; const float* x; const float* gain; float* part; unsigned* cnt; int panel0;
    __device__ __forceinline__ void fused(f32x4 (&acc)[2][2][4][2], const pg8::Unit& u, int wr, int wc, int fr, int fq, PG8_LAS unsigned char* lds, int wid, int lane) const {
        const int tid = wid * 64 + lane;
        const int row0 = u.pm * 256 + wr * 64 + fr, col0 = u.pn * 256 + wc * 32 + 4 * fq;
        PG8_LAS float* sl = (PG8_LAS float*)lds;
        float ss[2][4];
#pragma unroll
        for (int ai = 0; ai < 2; ++ai) {
            f32x4 xv[4][2][2];
#pragma unroll
            for (int m = 0; m < 4; ++m) {
                const float* xr = x + (size_t)(row0 + ai * 128 + m * 16) * 1024 + col0;
#pragma unroll
                for (int bj = 0; bj < 2; ++bj)
#pragma unroll
                    for (int n = 0; n < 2; ++n) xv[m][bj][n] = __builtin_nontemporal_load((const f32x4*)(xr + bj * 128 + n * 16));
            }
            __builtin_amdgcn_sched_barrier(0);
#pragma unroll
            for (int m = 0; m < 4; ++m) {
                float sacc = 0.f;
#pragma unroll
                for (int bj = 0; bj < 2; ++bj)
#pragma unroll
                    for (int n = 0; n < 2; ++n) {
                        const f32x4 v = acc[ai][bj][m][n] + xv[m][bj][n];
                        acc[ai][bj][m][n] = v;
                        sacc += v[0] * v[0] + v[1] * v[1] + v[2] * v[2] + v[3] * v[3];
                    }
                sacc += __shfl_xor(sacc, 16); sacc += __shfl_xor(sacc, 32);
                ss[ai][m] = sacc;
            }
            __builtin_amdgcn_sched_barrier(0);
        }
        if (fq == 0) {
#pragma unroll
            for (int ai = 0; ai < 2; ++ai)
#pragma unroll
                for (int m = 0; m < 4; ++m) sl[(ai * 128 + wr * 64 + m * 16 + fr) * 4 + wc] = ss[ai][m];
        }
        __syncthreads();
        float* slot = part + ((size_t)(panel0 + u.pm) * 4) * 256;
        if (tid < 256) {
            const float tot = sl[tid * 4 + 0] + sl[tid * 4 + 1] + sl[tid * 4 + 2] + sl[tid * 4 + 3];
            __hip_atomic_store(slot + (size_t)u.pn * 256 + tid, tot, __ATOMIC_RELAXED, __HIP_MEMORY_SCOPE_AGENT);
        }
        asm volatile("s_waitcnt vmcnt(0)" ::: "memory");
        __syncthreads();
        if (tid == 0) {
            unsigned* c = cnt + panel0 + u.pm;
            __hip_atomic_fetch_add(c, 1u, __ATOMIC_RELAXED, __HIP_MEMORY_SCOPE_AGENT);
            unsigned sp = 0;
            while (__hip_atomic_load(c, __ATOMIC_RELAXED, __HIP_MEMORY_SCOPE_AGENT) < 4u) { __builtin_amdgcn_s_sleep(1); if (++sp > (1u << 22)) break; }
        }
        __syncthreads();
        if (tid < 256) {
            float t = 0.f;
#pragma unroll
            for (int q = 0; q < 4; ++q) t += __hip_atomic_load(slot + (size_t)q * 256 + tid, __ATOMIC_RELAXED, __HIP_MEMORY_SCOPE_AGENT);
            sl[1024 + tid] = rsqrtf(t * (1.f / 1024.f) + 1e-6f);
        }
        __syncthreads();
#pragma unroll
        for (int ai = 0; ai < 2; ++ai)
#pragma unroll
            for (int m = 0; m < 4; ++m) {
                const int rl = ai * 128 + wr * 64 + m * 16 + fr;
                const float rs = sl[1024 + rl];
                float* yr = y + (size_t)(u.pm * 256 + rl) * 1024 + col0;
#pragma unroll
                for (int bj = 0; bj < 2; ++bj)
#pragma unroll
                    for (int n = 0; n < 2; ++n) {
                        const f32x4 g = *(const f32x4*)(gain + col0 + bj * 128 + n * 16);
                        __builtin_nontemporal_store(acc[ai][bj][m][n] * rs * g, (f32x4*)(yr + bj * 128 + n * 16));
                    }
                __builtin_amdgcn_sched_barrier(0);
            }
        __syncthreads();
    }
};
__device__ void phase_g3(const Params& p, char* lds) {
    const bf16_t* va = (const bf16_t*)(p.ws + OFF_SEND);
    const bf16_t* vb = (const bf16_t*)(p.ws + OFF_REGC);
    const bf16_t* sg = (const bf16_t*)(p.out + O_Y);
    bf16_t* m = (bf16_t*)(p.ws + OFF_REGA);
    unsigned* cntS = (unsigned*)(p.ws + OFF_BAR) + 3584 + 200;
    const int bx = blockIdx.x;
    const int nstep = (bx >= 248) ? 1 : (bx >= 16 && bx < 24) ? 3 : 2;
    for (int step = (bx < 16 ? -1 : 0); step < nstep; ++step) {
        const bool smp_tile = step < 0;
        const int tile = smp_tile ? 512 + bx : (step == 2 ? 488 + bx : bx + 256 * step);
        const int mt = tile >> 2, nt = tile & 3, row0 = mt * 128, col0 = nt * 256;
        f32x4 acc[4][4]; zero_acc(acc);
        gemm_acc<2, 4>(acc, va, 512, (const bf16_t*)(p.ws + OFF_WTPA), 512, 512, row0, col0, lds);
        f32x4 acc2[4][4]; zero_acc(acc2);
        gemm_acc<2, 4>(acc2, vb, 1024, (const bf16_t*)(p.ws + OFF_WTPB), 1024, 1024, row0, col0, lds);
        {
            const int lane = threadIdx.x & 63, wid = threadIdx.x >> 6, wr = wid / 4, wc = wid % 4, fr = lane & 15, fq = lane >> 4;
#pragma unroll
            for (int mh = 0; mh < 2; ++mh) {
              u32x2 gav[2][4], gbv[2][4];
#pragma unroll
              for (int ml = 0; ml < 2; ++ml)
#pragma unroll
                for (int ni = 0; ni < 4; ++ni) {
                    const int r = row0 + wr * 64 + (mh * 2 + ml) * 16 + fr, c = col0 + wc * 64 + ni * 16 + fq * 4;
                    gav[ml][ni] = *(const u32x2*)(sg + (size_t)r * 2048 + c); gbv[ml][ni] = *(const u32x2*)(sg + (size_t)r * 2048 + 1024 + c);
                }
              __builtin_amdgcn_sched_barrier(0);
#pragma unroll
              for (int ml = 0; ml < 2; ++ml) {
                const int mi = mh * 2 + ml;
#pragma unroll
                for (int ni = 0; ni < 4; ++ni) {
                    const int r = row0 + wr * 64 + mi * 16 + fr, c = col0 + wc * 64 + ni * 16 + fq * 4;
                    const u32x2 ga = gav[ml][ni], gb = gbv[ml][ni];
                    const f32x4 a = acc[mi][ni], b = acc2[mi][ni];
                    u32x2 o;
                    o[0] = cvt_pk_bf16(bflo(ga[0]) * a[0] + bflo(gb[0]) * b[0], bfhi(ga[0]) * a[1] + bfhi(gb[0]) * b[1]);
                    o[1] = cvt_pk_bf16(bflo(ga[1]) * a[2] + bflo(gb[1]) * b[2], bfhi(ga[1]) * a[3] + bfhi(gb[1]) * b[3]);
                    if (smp_tile) {
                        __hip_atomic_store((unsigned*)(m + (size_t)r * 1024 + c), o[0], __ATOMIC_RELAXED, __HIP_MEMORY_SCOPE_AGENT);
                        __hip_atomic_store((unsigned*)(m + (size_t)r * 1024 + c) + 1, o[1], __ATOMIC_RELAXED, __HIP_MEMORY_SCOPE_AGENT);
                    } else *(u32x2*)(m + (size_t)r * 1024 + c) = o;
                }
              }
              __builtin_amdgcn_sched_barrier(0);
            }
        }
        if (smp_tile) {
            asm volatile("s_waitcnt vmcnt(0)" ::: "memory");
            __syncthreads();
            if (threadIdx.x == 0) __hip_atomic_fetch_add(cntS, 1u, __ATOMIC_RELAXED, __HIP_MEMORY_SCOPE_AGENT);
        }
    }
    if (bx >= 248) {
        if (threadIdx.x == 0) { unsigned sp = 0; while (__hip_atomic_load(cntS, __ATOMIC_RELAXED, __HIP_MEMORY_SCOPE_AGENT) < 16u) { __builtin_amdgcn_s_sleep(2); if (++sp > (1u << 22)) break; } }
        __syncthreads();
        float* part = (float*)(p.ws + OFF_PEND);
        unsigned* cnt = (unsigned*)(p.ws + OFF_BAR) + 3584;
        EpiNorm e{p.out + O_Y + (size_t)NPTOK * 1024, p.in[1], p.in[27], part, cnt, 64};
        run_gemm256(lds, (const bf16_t*)(p.ws + OFF_REGA) + (size_t)NPTOK * 1024, (const bf16_t*)(p.ws + OFF_WTOUT), NTOK - NPTOK, 1024, 1024, e, 248);
    }
}
__device__ void phase_g4(const Params& p, char* lds) {
    float* part = (float*)(p.ws + OFF_PEND);
    unsigned* cnt = (unsigned*)(p.ws + OFF_BAR) + 3584;
    {
        EpiNorm e{p.out + O_Y, p.in[0], p.in[27], part, cnt, 0};
        run_gemm256(lds, (const bf16_t*)(p.ws + OFF_REGA), (const bf16_t*)(p.ws + OFF_WTOUT), NPTOK, 1024, 1024, e);
    }
}

__device__ void phase_n5(const Params& p) {
    const int lane = threadIdx.x & 63, wid = __builtin_amdgcn_readfirstlane(threadIdx.x >> 6);
    for (int item = blockIdx.x; item < NTOK / 16; item += gridDim.x) {
        const int tok0 = item * 16 + wid * 2;
        f32x4 v[2][4];
#pragma unroll
        for (int rr = 0; rr < 2; ++rr) {
            const float* y = p.out + O_Y + (size_t)(tok0 + rr) * 1024 + lane * 4;
#pragma unroll
            for (int i = 0; i < 4; ++i) v[rr][i] = *(const f32x4*)(y + i * 256);
        }
        f32x4 g[4];
#pragma unroll
        for (int i = 0; i < 4; ++i) g[i] = *(const f32x4*)(p.in[27] + lane * 4 + i * 256);
#pragma unroll
        for (int rr = 0; rr < 2; ++rr) {
            float ss = 0.f;
#pragma unroll
            for (int i = 0; i < 4; ++i) ss += v[rr][i][0] * v[rr][i][0] + v[rr][i][1] * v[rr][i][1] + v[rr][i][2] * v[rr][i][2] + v[rr][i][3] * v[rr][i][3];
#pragma unroll
            for (int o = 32; o; o >>= 1) ss += __shfl_xor(ss, o);
            const float rs = rsqrtf(ss * (1.f / 1024.f) + 1e-6f);
            float* y = p.out + O_Y + (size_t)(tok0 + rr) * 1024 + lane * 4;
#pragma unroll
            for (int i = 0; i < 4; ++i) *(f32x4*)(y + i * 256) = v[rr][i] * rs * g[i];
        }
    }
}

__device__ __forceinline__ void run_phase(const Params& p, int ph, char* lds) {
    switch (ph) {
        case 0: phase_prep(p, lds); break;
        case 1: phase_gemm1(p, lds); break;
        case 2: phase_m1(p, lds); break;
        case 3: phase_m2(p); break;
        case 4: phase_m3(p, lds); break;
        case 5: phase_g2(p, lds); break;
        case 6: phase_g3(p, lds); break;
        case 7: phase_g4(p, lds); break;
        default: phase_n5(p); break;
    }
}

typedef const __attribute__((address_space(4))) Params* KernargP;
__device__ __forceinline__ Params load_params() {
#if defined(__HIP_DEVICE_COMPILE__)
    KernargP kp = (KernargP)__builtin_amdgcn_kernarg_segment_ptr();
    asm volatile("" : "+s"(kp));
    return *kp;
#else
    return Params{};
#endif
}

#if MULTI
template <int PH>
__global__ void __launch_bounds__(NT) phase_kernel(Params p) {
    __shared__ __attribute__((aligned(16))) char lds[LDS_BYTES];
    run_phase(p, PH, lds);
}
#else
__global__ void __launch_bounds__(NT) hybrid_s5_rglru_megakernel(Params p, int use_cg) {
    __shared__ __attribute__((aligned(16))) char lds[LDS_BYTES];
    __shared__ uint4 xbw;
    if (threadIdx.x == 0) xbw = make_uint4(0u, 0u, 0u, 0u);
    __syncthreads();
    XcdBarrier xb = xcd_barrier_post((unsigned*)(p.ws + OFF_BAR), (volatile LAS unsigned*)&xbw);
    if (use_cg) cg::this_grid().sync();
    { const Params q = load_params(); phase_prep(q, lds); }  xcd_barrier(xb);
    { const Params q = load_params(); phase_gemm1(q, lds); } xcd_barrier(xb);
    { const Params q = load_params(); phase_m1(q, lds); }    xcd_barrier(xb);
    { const Params q = load_params(); phase_m2(q); }         xcd_barrier(xb);
    { const Params q = load_params(); phase_m3(q, lds); }    xcd_barrier(xb);
    { const Params q = load_params(); phase_g2(q, lds); }    xcd_barrier(xb);
    { const Params q = load_params(); phase_g3(q, lds); }    xcd_barrier(xb);
    { const Params q = load_params(); phase_g4(q, lds); }
}
#endif

extern "C" void kernel_launch(void* const* d_in, const int* in_sizes, int n_in, void* d_out, int out_size, void* d_ws, size_t ws_size,
                              hipStream_t stream) {
    Params p{};
    for (int i = 0; i < 28; ++i) p.in[i] = (const float*)d_in[i];
    p.out = (float*)d_out; p.ws = (char*)d_ws;
#if MULTI
    phase_kernel<0><<<256, NT, 0, stream>>>(p);
    phase_kernel<1><<<256, NT, 0, stream>>>(p);
    phase_kernel<2><<<256, NT, 0, stream>>>(p);
    phase_kernel<3><<<256, NT, 0, stream>>>(p);
    phase_kernel<4><<<256, NT, 0, stream>>>(p);
    phase_kernel<5><<<256, NT, 0, stream>>>(p);
    phase_kernel<6><<<256, NT, 0, stream>>>(p);
    phase_kernel<7><<<256, NT, 0, stream>>>(p);
#else
    static int grid_blocks = 0;
    if (!grid_blocks) {
        int dev = 0, cus = 0, per_cu = 0;
        hipGetDevice(&dev);
        hipDeviceGetAttribute(&cus, hipDeviceAttributeMultiprocessorCount, dev);
        hipOccupancyMaxActiveBlocksPerMultiprocessor(&per_cu, hybrid_s5_rglru_megakernel, NT, 0);
        if (per_cu > 1) per_cu = 1;
        grid_blocks = cus * (per_cu > 0 ? per_cu : 1);
    }
    hipMemsetAsync(d_ws, 0, 16384, stream);
    int use_cg = 0;
    void* args[] = {&p, &use_cg};
    hipError_t e = hipLaunchCooperativeKernel((void*)hybrid_s5_rglru_megakernel, dim3(grid_blocks), dim3(NT), args, 0, stream);
    if (e != hipSuccess) fprintf(stderr, "cooperative launch failed: %s (grid %d)\n", hipGetErrorString(e), grid_blocks);
#endif
}
```
